# Optimizing an MI355X kernel written in HIP

```python
import jax, jax.numpy as jnp
from jax import lax
import numpy as np

D_MODEL = 2048
BATCH = 4
SEQ = 4096
DEPTH = 4
DEC_BATCH = 2
DEC_SEQ = 4096
PAST_LEN = 128

N_MIXERS = 3
N_LAYERS_A = (DEPTH + 2) // 3
N_LAYERS_B = (DEPTH + 1) // 3
N_LAYERS_C = DEPTH // 3
BLOCK = 128
HEAD_DIM = 128
EPS = 1e-6
NEG_INF = -1e30
GMLP_HALF = 2 * D_MODEL
GMLP_GROUPS = 8
GMLP_GDIM = GMLP_HALF // GMLP_GROUPS
N_HEADS = D_MODEL // HEAD_DIM
N_KV_HEADS = 4
KV_GROUP = N_HEADS // N_KV_HEADS
WINDOW = 128
N_BUCKETS = 32
MAX_DISTANCE = 128
D_RNN = ((4 * D_MODEL // 3 + 255) // 256) * 256
RNN_BLOCKS = 16
RNN_BDIM = D_RNN // RNN_BLOCKS
CONV_WIDTH = 4
CONV_LEFT = 2
LRU_C = 8.0
MEM_LEN = 256
MEM_HEADS = 4
MEM_WIDTH = MEM_HEADS * HEAD_DIM
D_FF = ((8 * D_MODEL // 3 + 255) // 256) * 256
N_NORMS = 7

kernel_name = 'hybrid_bidir_encoder'


def rmsnorm(x, g):
    xf = x.astype(jnp.float32)
    y = xf * lax.rsqrt(jnp.mean(xf * xf, axis=-1, keepdims=True) + EPS)
    return (y * g.astype(jnp.float32)).astype(x.dtype)


def layernorm(x, g, b):
    xf = x.astype(jnp.float32)
    mu = jnp.mean(xf, axis=-1, keepdims=True)
    xc = xf - mu
    var = jnp.mean(xc * xc, axis=-1, keepdims=True)
    return (xc * lax.rsqrt(var + EPS) * g.astype(jnp.float32) + b.astype(jnp.float32)).astype(x.dtype)


def t5_bucket(rel):
    half = N_BUCKETS // 2
    exact = half // 2
    n = np.abs(rel)
    large = exact + (np.log(np.maximum(n, 1) / exact) / np.log(MAX_DISTANCE / exact) * (half - exact)).astype(np.int32)
    large = np.minimum(large, half - 1)
    return (np.where(rel > 0, half, 0) + np.where(n < exact, n, large)).astype(np.int32)


def gmlp_mixer(h, w_in, ln_g, ln_b, w_s, b_s, w_out):
    B, S, _ = h.shape
    z = jax.nn.gelu(h @ w_in)
    u, v = jnp.split(z, 2, axis=-1)
    v = layernorm(v, ln_g, ln_b)
    v = v.reshape(B, S // BLOCK, BLOCK, GMLP_GROUPS, GMLP_GDIM)
    v = jnp.einsum('gpq,bnqgc->bnpgc', w_s, v) + b_s.T[None, None, :, :, None]
    return (u * v.reshape(B, S, GMLP_HALF)) @ w_out


def window_attention(h, w_qkv, sink, w_o, rel_table):
    B, S, _ = h.shape
    NB = S // BLOCK
    q, k, v = jnp.split(h @ w_qkv, [N_HEADS * HEAD_DIM, (N_HEADS + N_KV_HEADS) * HEAD_DIM], axis=-1)
    q = q.reshape(B, NB, BLOCK, N_KV_HEADS, KV_GROUP, HEAD_DIM)

    def band(t):
        t = t.reshape(B, S, N_KV_HEADS, HEAD_DIM)
        t = jnp.pad(t, ((0, 0), (BLOCK, BLOCK), (0, 0), (0, 0))).reshape(B, NB + 2, BLOCK, N_KV_HEADS, HEAD_DIM)
        return jnp.concatenate([t[:, :-2], t[:, 1:-1], t[:, 2:]], axis=2)

    kb, vb = band(k), band(v)
    s = jnp.einsum('bnqkgd,bnjkd->bnkgqj', q, kb).astype(jnp.float32) * (HEAD_DIM ** -0.5)
    rel = np.arange(3 * BLOCK)[None, :] - BLOCK - np.arange(BLOCK)[:, None]
    bias = rel_table[t5_bucket(rel)].astype(jnp.float32)
    bias = jnp.transpose(bias, (2, 0, 1)).reshape(N_KV_HEADS, KV_GROUP, BLOCK, 3 * BLOCK)
    kpos = np.arange(NB)[:, None, None] * BLOCK - BLOCK + np.arange(3 * BLOCK)[None, None, :]
    qpos = np.arange(NB)[:, None, None] * BLOCK + np.arange(BLOCK)[None, :, None]
    valid = (kpos >= 0) & (kpos < S) & (np.abs(kpos - qpos) <= WINDOW)
    s = jnp.where(valid[None, :, None, None], s + bias[None, None], NEG_INF)
    sk = sink.astype(jnp.float32).reshape(1, 1, N_KV_HEADS, KV_GROUP, 1, 1)
    m = jnp.maximum(jnp.max(s, axis=-1, keepdims=True), sk)
    p = jnp.exp(s - m)
    p = p / (jnp.sum(p, axis=-1, keepdims=True) + jnp.exp(sk - m))
    o = jnp.einsum('bnkgqj,bnjkd->bnqkgd', p.astype(h.dtype), vb).reshape(B, S, N_HEADS * HEAD_DIM)
    return o @ w_o


def _lin_combine(left, right):
    a1, b1 = left
    a2, b2 = right
    return a1 * a2, a2 * b1 + b2


def rglru_scan(x, w_a, b_a, w_x, b_x, lam, reverse):
    B, S, _ = x.shape
    xb = x.reshape(B, S, RNN_BLOCKS, RNN_BDIM)
    r = jax.nn.sigmoid((jnp.einsum('bshi,hij->bshj', xb, w_a).reshape(B, S, D_RNN) + b_a).astype(jnp.float32))
    gi = jax.nn.sigmoid((jnp.einsum('bshi,hij->bshj', xb, w_x).reshape(B, S, D_RNN) + b_x).astype(jnp.float32))
    log_a = -LRU_C * r * jax.nn.softplus(-lam.astype(jnp.float32))
    a = jnp.exp(log_a)
    u = jnp.sqrt(-jnp.expm1(2.0 * log_a)) * (gi * x.astype(jnp.float32))
    _, hs = lax.associative_scan(_lin_combine, (a, u), axis=1, reverse=reverse)
    return hs


def rglru_block(h, w_in, conv_w, conv_b, w_a, b_a, w_x, b_x, lam, w_out):
    S = h.shape[1]
    gate_br, rnn_br = jnp.split(h @ w_in, 2, axis=-1)
    xp = jnp.pad(rnn_br, ((0, 0), (CONV_LEFT, CONV_WIDTH - 1 - CONV_LEFT), (0, 0)))
    xc = conv_b + xp[:, 0:S] * conv_w[0]
    for k in range(1, CONV_WIDTH):
        xc = xc + xp[:, k:k + S] * conv_w[k]
    y = (rglru_scan(xc, w_a[0], b_a[0], w_x[0], b_x[0], lam[0], False)
         + rglru_scan(xc, w_a[1], b_a[1], w_x[1], b_x[1], lam[1], True))
    return (jax.nn.gelu(gate_br) * y.astype(h.dtype)) @ w_out


def memory_attention(h, mem, w_q, w_kv, w_o):
    B, S, _ = h.shape
    M = mem.shape[1]
    q = (h @ w_q).reshape(B, S, MEM_HEADS, HEAD_DIM)
    k, v = jnp.split(mem @ w_kv, 2, axis=-1)
    k = k.reshape(B, M, MEM_HEADS, HEAD_DIM)
    v = v.reshape(B, M, MEM_HEADS, HEAD_DIM)
    s = jnp.einsum('bshd,bmhd->bhsm', q, k).astype(jnp.float32) * (HEAD_DIM ** -0.5)
    p = jax.nn.softmax(s, axis=-1)
    o = jnp.einsum('bhsm,bmhd->bshd', p.astype(h.dtype), v).reshape(B, S, MEM_WIDTH)
    return o @ w_o


def swiglu(h, w_gate_up, w_down):
    g, u = jnp.split(h @ w_gate_up, 2, axis=-1)
    return (jax.nn.silu(g) * u) @ w_down


def trunk(x, mem, p):
    for i in range(DEPTH):
        kind, j = i % N_MIXERS, i // N_MIXERS
        g = p['norms'][i]
        h = rmsnorm(x, g[0])
        if kind == 0:
            h = gmlp_mixer(h, p['a_w_in'][j], p['a_ln_g'][j], p['a_ln_b'][j], p['a_w_s'][j], p['a_b_s'][j], p['a_w_out'][j])
        elif kind == 1:
            h = window_attention(h, p['b_w_qkv'][j], p['b_sink'][j], p['b_w_o'][j], p['rel_bias'])
        else:
            h = rglru_block(h, p['c_w_in'][j], p['c_conv_w'][j], p['c_conv_b'][j], p['c_w_a'][j], p['c_b_a'][j],
                            p['c_w_x'][j], p['c_b_x'][j], p['c_lam'][j], p['c_w_out'][j])
        x = x + rmsnorm(h, g[1])
        h = memory_attention(rmsnorm(x, g[2]), rmsnorm(mem, g[4]), p['m_w_q'][i], p['m_w_kv'][i], p['m_w_o'][i])
        x = x + rmsnorm(h, g[3])
        h = swiglu(rmsnorm(x, g[5]), p['f_w_gate_up'][i], p['f_w_down'][i])
        x = x + rmsnorm(h, g[6])
    return x


def _normal(k, shape, scale):
    return jax.random.normal(k, shape, jnp.float32) * scale


def setup_inputs(seed: int = 0) -> dict:
    key = jax.random.key(seed)
    ks = list(jax.random.split(key, 32))
    D = D_MODEL
    QKV = (N_HEADS + 2 * N_KV_HEADS) * HEAD_DIM
    a8 = jax.random.uniform(ks[27], (N_LAYERS_C, 2, D_RNN), jnp.float32, 0.9, 0.999)
    a_base = a8 ** (1.0 / LRU_C)
    c_lam = jnp.log(a_base) - jnp.log1p(-a_base)
    return {
        'x_prompt': _normal(ks[0], (BATCH, SEQ, D), 1.0),
        'x_sample': _normal(ks[1], (DEC_BATCH, DEC_SEQ, D), 1.0),
        'mem_prompt': _normal(ks[2], (BATCH, MEM_LEN, D), 1.0),
        'mem_sample': _normal(ks[3], (DEC_BATCH, MEM_LEN, D), 1.0),
        'norms': 1.0 + _normal(ks[4], (DEPTH, N_NORMS, D), 0.05),
        'rel_bias': _normal(ks[5], (N_BUCKETS, N_HEADS), 0.1),
        'a_w_in': _normal(ks[6], (N_LAYERS_A, D, 2 * GMLP_HALF), D ** -0.5),
        'a_ln_g': 1.0 + _normal(ks[7], (N_LAYERS_A, GMLP_HALF), 0.05),
        'a_ln_b': _normal(ks[8], (N_LAYERS_A, GMLP_HALF), 0.02),
        'a_w_s': _normal(ks[9], (N_LAYERS_A, GMLP_GROUPS, BLOCK, BLOCK), BLOCK ** -0.5),
        'a_b_s': 1.0 + _normal(ks[10], (N_LAYERS_A, GMLP_GROUPS, BLOCK), 0.02),
        'a_w_out': _normal(ks[11], (N_LAYERS_A, GMLP_HALF, D), GMLP_HALF ** -0.5),
        'b_w_qkv': _normal(ks[12], (N_LAYERS_B, D, QKV), D ** -0.5),
        'b_sink': _normal(ks[13], (N_LAYERS_B, N_HEADS), 0.5),
        'b_w_o': _normal(ks[14], (N_LAYERS_B, N_HEADS * HEAD_DIM, D), (N_HEADS * HEAD_DIM) ** -0.5),
        'c_w_in': _normal(ks[15], (N_LAYERS_C, D, 2 * D_RNN), D ** -0.5),
        'c_conv_w': _normal(ks[16], (N_LAYERS_C, CONV_WIDTH, D_RNN), CONV_WIDTH ** -0.5),
        'c_conv_b': _normal(ks[17], (N_LAYERS_C, D_RNN), 0.02),
        'c_w_a': _normal(ks[18], (N_LAYERS_C, 2, RNN_BLOCKS, RNN_BDIM, RNN_BDIM), RNN_BDIM ** -0.5),
        'c_b_a': _normal(ks[19], (N_LAYERS_C, 2, D_RNN), 0.02),
        'c_w_x': _normal(ks[20], (N_LAYERS_C, 2, RNN_BLOCKS, RNN_BDIM, RNN_BDIM), RNN_BDIM ** -0.5),
        'c_b_x': _normal(ks[21], (N_LAYERS_C, 2, D_RNN), 0.02),
        'c_lam': c_lam,
        'c_w_out': _normal(ks[22], (N_LAYERS_C, D_RNN, D), D_RNN ** -0.5),
        'm_w_q': _normal(ks[23], (DEPTH, D, MEM_WIDTH), D ** -0.5),
        'm_w_kv': _normal(ks[24], (DEPTH, D, 2 * MEM_WIDTH), D ** -0.5),
        'm_w_o': _normal(ks[25], (DEPTH, MEM_WIDTH, D), MEM_WIDTH ** -0.5),
        'f_w_gate_up': _normal(ks[26], (DEPTH, D, 2 * D_FF), D ** -0.5),
        'f_w_down': _normal(ks[28], (DEPTH, D_FF, D), D_FF ** -0.5),
    }


def reference(x_prompt, x_sample, mem_prompt, mem_sample, norms, rel_bias,
              a_w_in, a_ln_g, a_ln_b, a_w_s, a_b_s, a_w_out,
              b_w_qkv, b_sink, b_w_o,
              c_w_in, c_conv_w, c_conv_b, c_w_a, c_b_a, c_w_x, c_b_x, c_lam, c_w_out,
              m_w_q, m_w_kv, m_w_o, f_w_gate_up, f_w_down):
    p = {
        'norms': norms, 'rel_bias': rel_bias,
        'a_w_in': a_w_in, 'a_ln_g': a_ln_g, 'a_ln_b': a_ln_b, 'a_w_s': a_w_s, 'a_b_s': a_b_s, 'a_w_out': a_w_out,
        'b_w_qkv': b_w_qkv, 'b_sink': b_sink, 'b_w_o': b_w_o,
        'c_w_in': c_w_in, 'c_conv_w': c_conv_w, 'c_conv_b': c_conv_b, 'c_w_a': c_w_a, 'c_b_a': c_b_a,
        'c_w_x': c_w_x, 'c_b_x': c_b_x, 'c_lam': c_lam, 'c_w_out': c_w_out,
        'm_w_q': m_w_q, 'm_w_kv': m_w_kv, 'm_w_o': m_w_o,
        'f_w_gate_up': f_w_gate_up, 'f_w_down': f_w_down,
    }
    y_prompt = trunk(x_prompt, mem_prompt, p)
    y_sample = trunk(x_sample, mem_sample, p)
    return (y_prompt, y_sample)
```

```cpp
#include <hip/hip_runtime.h>
#include <cstdio>
#include <cstdint>

#ifndef MK_MULTI
#define MK_MULTI 1
#endif

namespace pg8 {
#define PG8_LAS __attribute__((address_space(3)))
typedef unsigned short bf16_t;
typedef short bf16x8 __attribute__((ext_vector_type(8)));
typedef float f32x4 __attribute__((ext_vector_type(4)));
typedef float f32x2 __attribute__((ext_vector_type(2)));
typedef unsigned u32x4 __attribute__((ext_vector_type(4)));
typedef unsigned u32x2 __attribute__((ext_vector_type(2)));
typedef _Float16 f16x4 __attribute__((ext_vector_type(4)));
constexpr int BM = 256, BK = 64, HALF = 128, HTB = HALF * BK * 2  , STAGE_BYTES = 8 * HTB, NXCD = 8, WGM = 8;

__host__ __device__ __forceinline__ int lds_byte(int r, int c) { const int st = (r >> 4) * 2 + (c >> 5), rr = r & 15, cc = c & 31, ob = rr * 64 + cc * 2; return st * 1024 + (ob ^ (((ob >> 9) & 1) << 5)); }
__host__ __device__ __forceinline__ void stage_rc(int b, int& R, int& C) { const int st = b / 1024, sb = b % 1024, swz = sb ^ (((sb >> 9) & 1) << 5); R = (st >> 1) * 16 + swz / 64; C = (st & 1) * 32 + (swz % 64) / 2; }
__host__ __device__ __forceinline__ int perm32(int rho) { const int n = rho >> 4, i = rho & 15; return 8 * (i >> 2) + 4 * n + (i & 3); }

struct Unit { int pm, pn; };
struct Gemm { const bf16_t* A; const bf16_t* Bt; int lda, ldb, K; };

struct StaticOrder {
    int nM, nN, nwg, G, c; size_t tA, tB;
    __device__ void init(int nM_, int nN_, int G_, int c_, int lda, int ldb) { nM = nM_; nN = nN_; nwg = nM * nN; G = G_; c = c_; tA = (size_t)BM * lda * 2; tB = (size_t)BM * ldb * 2; }
    __device__ bool next(int i, Unit& u) const {
        const long L = (long)i * G + c; if (L >= nwg) return false;
        int wgid = (int)L; { const int q = nwg / NXCD, r = nwg % NXCD, xcd = wgid % NXCD, off = wgid / NXCD; wgid = (xcd < r ? xcd * (q + 1) : r * (q + 1) + (xcd - r) * q) + off; }
        const int nig = WGM * nN, gid = wgid / nig, fm = gid * WGM, gsz = (nM - fm) < WGM ? (nM - fm) : WGM;
        u.pm = fm + ((wgid % nig) % gsz); u.pn = (wgid % nig) / gsz; return true;
    }
    __device__ __forceinline__ size_t offA(const Unit& u) const { return (size_t)u.pm * tA; }
    __device__ __forceinline__ size_t offB(const Unit& u) const { return (size_t)u.pn * tB; }
    __device__ __forceinline__ void a_ready(const Unit&) const {}
    __device__ __forceinline__ void done(const Unit&) const {}
};
struct MemProjOrder {
    int G, c; size_t tA, tB;
    __device__ bool next(int i, Unit& u) const {
        const int L = i * G + c; if (L >= 216) return false;
        if (L < 192) { u.pm = L >> 1; u.pn = L & 1; } else { const int r = L - 192; u.pm = 96 + (r >> 2); u.pn = 2 + (r & 3); }
        return true;
    }
    __device__ __forceinline__ size_t offA(const Unit& u) const { return (size_t)u.pm * tA; }
    __device__ __forceinline__ size_t offB(const Unit& u) const { return (size_t)u.pn * tB; }
    __device__ __forceinline__ void a_ready(const Unit&) const {}
    __device__ __forceinline__ void done(const Unit&) const {}
};
struct GateOrder {
    int G, c;
    __device__ bool next(int i, Unit& u) const {
        const int L = i * G + c; if (L >= 96 * 48) return false;
        u.pm = L / 48; u.pn = L % 48; return true;
    }
    __device__ __forceinline__ size_t offA(const Unit& u) const { return (size_t)u.pm * (256 * 4096 * 2) + (size_t)(u.pn / 3) * 512; }
    __device__ __forceinline__ size_t offB(const Unit& u) const { return (size_t)u.pn * (256 * 256 * 2); }
    __device__ __forceinline__ void a_ready(const Unit&) const {}
    __device__ __forceinline__ void done(const Unit&) const {}
};

__device__ __forceinline__ unsigned cvt_pk_bf16(float lo, float hi) { unsigned r; asm volatile("v_cvt_pk_bf16_f32 %0, %1, %2" : "=v"(r) : "v"(lo), "v"(hi)); return r; }
__device__ __forceinline__ float bf_lo(unsigned w) { return __uint_as_float(w << 16); }
__device__ __forceinline__ float bf_hi(unsigned w) { return __uint_as_float(w & 0xffff0000u); }
__device__ __forceinline__ float sigmoid_f(float x) { return __builtin_amdgcn_rcpf(1.0f + __builtin_amdgcn_exp2f(-1.4426950408889634f * x)); }
__device__ __forceinline__ float gelu_f(float x) { const float t = x * (1.0f + 0.044715f * x * x); return x * __builtin_amdgcn_rcpf(1.0f + __builtin_amdgcn_exp2f(-2.3022081981f * t)); }
__device__ __forceinline__ float silu_f(float x) { return x * sigmoid_f(x); }

struct EpiGen {
    static constexpr bool PERM = true, AFTER_DRAIN = false;
    bf16_t* O0; int ldc0, act0; bf16_t* O1; int ldc1, act1; int pn_split, pm_split;
    __device__ __forceinline__ void operator()(const f32x4 (&acc)[2][2][4][2], const Unit& u, int wr, int wc, int fr, int fq) const {
        const bool v1 = u.pn >= pn_split;
        bf16_t* base = v1 ? O1 : O0; const int ldc = v1 ? ldc1 : ldc0, act = v1 ? act1 : act0;
        const int row0 = (v1 ? u.pm - pm_split : u.pm) * BM + wr * 64 + fr, col0 = (v1 ? u.pn - pn_split : u.pn) * BM + wc * 32 + 8 * fq;
#pragma unroll
        for (int ai = 0; ai < 2; ++ai)
#pragma unroll
            for (int m = 0; m < 4; ++m) { bf16_t* rowp = base + (size_t)(row0 + ai * HALF + m * 16) * ldc + col0;
#pragma unroll
                for (int bj = 0; bj < 2; ++bj) { f32x4 v0 = acc[ai][bj][m][0], v1v = acc[ai][bj][m][1];
                    if (act == 1) {
#pragma unroll
                        for (int e = 0; e < 4; ++e) { v0[e] = gelu_f(v0[e]); v1v[e] = gelu_f(v1v[e]); } }
                    u32x4 w; w.x = cvt_pk_bf16(v0[0], v0[1]); w.y = cvt_pk_bf16(v0[2], v0[3]); w.z = cvt_pk_bf16(v1v[0], v1v[1]); w.w = cvt_pk_bf16(v1v[2], v1v[3]);
                    *(u32x4*)(rowp + bj * HALF) = w; } }
    }
};
struct EpiGeluStatsT {
    static constexpr bool PERM = true, AFTER_DRAIN = false;
    bf16_t* O; int ldc; f32x2* pst;
    __device__ __forceinline__ void operator()(const f32x4 (&acc)[2][2][4][2], const Unit& u, int wr, int wc, int fr, int fq) const {
        const int row0 = u.pm * BM + wr * 64 + fr, col0 = u.pn * BM + wc * 32 + 8 * fq;
        f32x4 s[2][2], q[2][2];
#pragma unroll
        for (int bj = 0; bj < 2; ++bj)
#pragma unroll
            for (int n = 0; n < 2; ++n) { s[bj][n] = (f32x4){0.f, 0.f, 0.f, 0.f}; q[bj][n] = (f32x4){0.f, 0.f, 0.f, 0.f}; }
#pragma unroll
        for (int ai = 0; ai < 2; ++ai)
#pragma unroll
            for (int m = 0; m < 4; ++m) { bf16_t* rowp = O + (size_t)(row0 + ai * HALF + m * 16) * ldc + col0;
#pragma unroll
                for (int bj = 0; bj < 2; ++bj) { f32x4 v0 = acc[ai][bj][m][0], v1v = acc[ai][bj][m][1];
#pragma unroll
                    for (int e = 0; e < 4; ++e) { v0[e] = gelu_f(v0[e]); v1v[e] = gelu_f(v1v[e]); }
                    s[bj][0] += v0; s[bj][1] += v1v; q[bj][0] += v0 * v0; q[bj][1] += v1v * v1v;
                    u32x4 w; w.x = cvt_pk_bf16(v0[0], v0[1]); w.y = cvt_pk_bf16(v0[2], v0[3]); w.z = cvt_pk_bf16(v1v[0], v1v[1]); w.w = cvt_pk_bf16(v1v[2], v1v[3]);
                    *(u32x4*)(rowp + bj * HALF) = w; } }
#pragma unroll
        for (int bj = 0; bj < 2; ++bj)
#pragma unroll
            for (int n = 0; n < 2; ++n)
#pragma unroll
                for (int e = 0; e < 4; ++e) { float a = s[bj][n][e], b = q[bj][n][e];
#pragma unroll
                    for (int o = 1; o < 16; o <<= 1) { a += __shfl_xor(a, o); b += __shfl_xor(b, o); }
                    s[bj][n][e] = a; q[bj][n][e] = b; }
        if (fr == 0) {
            const int slot = u.pm * 2 + wr;
#pragma unroll
            for (int bj = 0; bj < 2; ++bj)
#pragma unroll
                for (int n = 0; n < 2; ++n)
#pragma unroll
                    for (int e = 0; e < 4; ++e) pst[(size_t)(col0 + bj * HALF + 4 * n + e) * 32 + slot] = (f32x2){s[bj][n][e], q[bj][n][e]};
        }
    }
};
struct EpiSwiGLU {
    static constexpr bool PERM = true, AFTER_DRAIN = false;
    bf16_t* O; int ldc;
    __device__ __forceinline__ void operator()(const f32x4 (&acc)[2][2][4][2], const Unit& u, int wr, int wc, int fr, int fq) const {
        const int row0 = u.pm * BM + wr * 64 + fr, col0 = u.pn * HALF + wc * 32 + 8 * fq;
#pragma unroll
        for (int ai = 0; ai < 2; ++ai)
#pragma unroll
            for (int m = 0; m < 4; ++m) { bf16_t* rowp = O + (size_t)(row0 + ai * HALF + m * 16) * ldc + col0;
                f32x4 v0, v1v;
#pragma unroll
                for (int e = 0; e < 4; ++e) { v0[e] = silu_f(acc[ai][0][m][0][e]) * acc[ai][1][m][0][e]; v1v[e] = silu_f(acc[ai][0][m][1][e]) * acc[ai][1][m][1][e]; }
                u32x4 w; w.x = cvt_pk_bf16(v0[0], v0[1]); w.y = cvt_pk_bf16(v0[2], v0[3]); w.z = cvt_pk_bf16(v1v[0], v1v[1]); w.w = cvt_pk_bf16(v1v[2], v1v[3]);
                *(u32x4*)rowp = w; }
    }
};
struct EpiLRU {
    static constexpr bool PERM = false, AFTER_DRAIN = false;
    _Float16* LA; _Float16* UU; const bf16_t* XC; const float* b_a; const float* b_x; const float* spl8; unsigned dstride;
    __device__ __forceinline__ void operator()(const f32x4 (&acc)[2][2][4][2], const Unit& u, int wr, int wc, int fr, int fq_) const {
        int fq = fq_; const int h = u.pn / 3, j = u.pn - 3 * h;
        int row0 = u.pm * BM + wr * 64 + fr;
        asm volatile("" : "+v"(row0), "+v"(fq));
#pragma unroll
        for (int n = 0; n < 2; ++n) {
            const int s0 = j * 128 + wc * 32 + 16 * n + 4 * fq;
            if (s0 < 352) {
                const int d = s0 >= 176 ? 1 : 0, cb = s0 - 176 * d, ch = h * 176 + cb;
                const f32x4 ba = *(const f32x4*)(b_a + d * 2816 + ch), bx = *(const f32x4*)(b_x + d * 2816 + ch), sp = *(const f32x4*)(spl8 + d * 2816 + ch);
                const unsigned obase = (unsigned)d * dstride + (unsigned)ch, xbase = (unsigned)(h * 256 + cb);
#pragma unroll
                for (int ai = 0; ai < 2; ++ai)
#pragma unroll
                    for (int m = 0; m < 4; ++m) { const unsigned row = (unsigned)(row0 + ai * HALF + m * 16);
                        const u32x2 xw = *(const u32x2*)(XC + (row * 4096u + xbase));
                        const float xv[4] = {bf_lo(xw.x), bf_hi(xw.x), bf_lo(xw.y), bf_hi(xw.y)};
                        f16x4 la, uu;
#pragma unroll
                        for (int e = 0; e < 4; ++e) {
                            const float r = sigmoid_f(acc[ai][0][m][n][e] + ba[e]), gi = sigmoid_f(acc[ai][1][m][n][e] + bx[e]);
                            const float l = -sp[e] * r, x2 = 2.0f * l;
                            const float om = x2 > -0.05f ? -x2 * (1.0f + x2 * (0.5f + x2 * (0.16666667f + x2 * 0.041666668f))) : 1.0f - __builtin_amdgcn_exp2f(1.4426950408889634f * x2);
                            la[e] = (_Float16)l; uu[e] = (_Float16)(__builtin_sqrtf(om) * gi * xv[e]);
                        }
                        const unsigned o = obase + row * 2816u;
                        *(f16x4*)(LA + o) = la; *(f16x4*)(UU + o) = uu; asm volatile("" ::: "memory"); }
            }
        }
    }
};

template <class Epi, class Sched, bool ALIGN_EPI = false, bool SP2 = false>
__device__ __forceinline__ void gemm_phase(PG8_LAS unsigned char* lds, const Gemm g, const Sched& S, const Epi& E) {
    int tid = threadIdx.x; asm volatile("" : "+v"(tid));
    const int wid = __builtin_amdgcn_readfirstlane(tid >> 6), lane = tid & 63, wr = wid >> 2, wc = wid & 3, fr = lane & 15, fq = lane >> 4;
    int K = g.K; asm volatile("" : "+s"(K));
    const int nt = K / BK;
    unsigned voffA[2], voffB[2];
#pragma unroll
    for (int i = 0; i < 2; ++i) { int R, C; stage_rc(tid * 16 + i * 8192, R, C); const int Rb = Epi::PERM ? ((R & ~31) + perm32(R & 31)) : R;
        voffA[i] = (unsigned)(R * g.lda + C) * 2u; voffB[i] = (unsigned)(Rb * g.ldb + C) * 2u; }
    const size_t kstep = (size_t)(BK * 2);
    const size_t hstepA = (size_t)HALF * g.lda * 2, hstepB = (size_t)HALF * g.ldb * 2;
    const unsigned ldsw = (unsigned)wid * 1024u;
    const int aoff = lds_byte(wr * 64 + fr, fq * 8), boff = lds_byte(wc * 32 + fr, fq * 8);
#define PG8_SA(b, h) (((b) * 2 + (h)) * HTB)
#define PG8_SB(b, h) ((4 + (b) * 2 + (h)) * HTB)
#define PG8_STAGE(bufoff, gbase, voff) do { _Pragma("unroll") for (int _i = 0; _i < 2; ++_i) \
        __builtin_amdgcn_global_load_lds((const unsigned*)((const char*)(gbase) + (voff)[_i]), (PG8_LAS unsigned*)(lds + (bufoff) + ldsw + _i * 8192), 16, 0, 0); } while (0)
#define PG8_LDA(dst, b, h) do { _Pragma("unroll") for (int m = 0; m < 4; ++m) _Pragma("unroll") for (int k = 0; k < 2; ++k) dst[m][k] = *(const PG8_LAS bf16x8*)(lds + PG8_SA(b, h) + aoff + m * 2048 + k * 1024); } while (0)
#define PG8_LDB(dst, b, h) do { _Pragma("unroll") for (int n = 0; n < 2; ++n) _Pragma("unroll") for (int k = 0; k < 2; ++k) dst[n][k] = *(const PG8_LAS bf16x8*)(lds + PG8_SB(b, h) + boff + n * 2048 + k * 1024); } while (0)
#define PG8_MMA(ai, bj, At, Bt) do { __builtin_amdgcn_s_setprio(1); _Pragma("unroll") for (int m = 0; m < 4; ++m) _Pragma("unroll") for (int n = 0; n < 2; ++n) _Pragma("unroll") for (int k = 0; k < 2; ++k) \
        acc[ai][bj][m][n] = __builtin_amdgcn_mfma_f32_16x16x32_bf16(Bt[n][k], At[m][k], acc[ai][bj][m][n], 0, 0, 0); __builtin_amdgcn_s_setprio(0); } while (0)
#define PG8_WAIT_V(n) asm volatile("s_waitcnt vmcnt(" #n ")" ::: "memory")
#define PG8_WAIT_L(n) asm volatile("s_waitcnt lgkmcnt(" #n ")" ::: "memory")
#define PG8_BAR __builtin_amdgcn_s_barrier()
#define PG8_SCHED __builtin_amdgcn_sched_barrier(0)
    Unit cur, nxt; int ui = 0;
    if (!S.next(0, cur)) return;
    f32x4 acc[2][2][4][2];
#pragma unroll
    for (int a = 0; a < 2; ++a)
#pragma unroll
        for (int b = 0; b < 2; ++b)
#pragma unroll
            for (int m = 0; m < 4; ++m)
#pragma unroll
                for (int n = 0; n < 2; ++n) acc[a][b][m][n] = (f32x4){0.f, 0.f, 0.f, 0.f};
    bf16x8 At[4][2], B0[2][2], B1[2][2];
    const char* cA = (const char*)g.A + S.offA(cur); const char* cB = (const char*)g.Bt + S.offB(cur);
    S.a_ready(cur);
    if constexpr (SP2) {
        PG8_STAGE(PG8_SB(0, 0), cB, voffB); PG8_STAGE(PG8_SB(0, 1), cB + hstepB, voffB); PG8_STAGE(PG8_SA(0, 0), cA, voffA); PG8_STAGE(PG8_SA(0, 1), cA + hstepA, voffA);
        if (wr == 1) PG8_BAR;
        PG8_WAIT_V(2); PG8_BAR;
        PG8_STAGE(PG8_SB(1, 0), cB + kstep, voffB); PG8_STAGE(PG8_SA(1, 0), cA + kstep, voffA); PG8_STAGE(PG8_SB(1, 1), cB + hstepB + kstep, voffB);
        PG8_WAIT_V(6); PG8_BAR;
    } else {
        PG8_STAGE(PG8_SB(0, 0), cB, voffB); PG8_STAGE(PG8_SA(0, 0), cA, voffA); PG8_STAGE(PG8_SB(0, 1), cB + hstepB, voffB); PG8_STAGE(PG8_SA(0, 1), cA + hstepA, voffA);
        if (wr == 1) PG8_BAR;
        PG8_WAIT_V(4); PG8_BAR;
        PG8_STAGE(PG8_SB(1, 0), cB + kstep, voffB); PG8_STAGE(PG8_SA(1, 0), cA + kstep, voffA); PG8_STAGE(PG8_SB(1, 1), cB + hstepB + kstep, voffB);
        PG8_WAIT_V(6); PG8_BAR;
    }
    for (;;) {
        const bool has_next = S.next(ui + 1, nxt);
        const char* nA = has_next ? (const char*)g.A + S.offA(nxt) : cA; const char* nB = has_next ? (const char*)g.Bt + S.offB(nxt) : cB;
        for (int t = 0; t < nt; t += 2) {
            const bool last = (t == nt - 2);
            const char* a1 = cA + (size_t)(t + 1) * kstep;
            const char* a2 = last ? nA : cA + (size_t)(t + 2) * kstep; const char* b2 = last ? nB : cB + (size_t)(t + 2) * kstep;
            const char* a3 = a2 + kstep; const char* b3 = b2 + kstep;
            if (last && has_next) S.a_ready(nxt);
            if constexpr (SP2) {
            PG8_LDB(B0, 0, 0); PG8_LDB(B1, 0, 1); PG8_SCHED; PG8_LDA(At, 0, 0); PG8_STAGE(PG8_SA(1, 1), a1 + hstepA, voffA);
            PG8_WAIT_V(8); PG8_WAIT_L(0); PG8_BAR; PG8_MMA(0, 0, At, B0); PG8_MMA(0, 1, At, B1); PG8_BAR; PG8_SCHED;
            PG8_LDA(At, 0, 1); PG8_STAGE(PG8_SB(0, 0), b2, voffB); PG8_STAGE(PG8_SB(0, 1), b2 + hstepB, voffB); PG8_STAGE(PG8_SA(0, 0), a2, voffA);
            PG8_WAIT_V(8); PG8_WAIT_L(0); PG8_BAR; PG8_MMA(1, 0, At, B0); PG8_MMA(1, 1, At, B1); PG8_BAR; PG8_SCHED;
            PG8_LDB(B0, 1, 0); PG8_LDB(B1, 1, 1); PG8_SCHED; PG8_LDA(At, 1, 0); PG8_STAGE(PG8_SA(0, 1), a2 + hstepA, voffA);
            PG8_WAIT_V(8); PG8_WAIT_L(0); PG8_BAR; PG8_MMA(0, 0, At, B0); PG8_MMA(0, 1, At, B1); PG8_BAR; PG8_SCHED;
            PG8_LDA(At, 1, 1); PG8_STAGE(PG8_SB(1, 0), b3, voffB); PG8_STAGE(PG8_SB(1, 1), b3 + hstepB, voffB); PG8_STAGE(PG8_SA(1, 0), a3, voffA);
            PG8_WAIT_V(8); PG8_WAIT_L(0); PG8_BAR; PG8_MMA(1, 0, At, B0); PG8_MMA(1, 1, At, B1); PG8_BAR; PG8_SCHED;
            } else {
            PG8_LDB(B0, 0, 0); PG8_SCHED; PG8_LDA(At, 0, 0); PG8_STAGE(PG8_SA(1, 1), a1 + hstepA, voffA);
            PG8_WAIT_L(8); PG8_BAR; PG8_WAIT_L(0); PG8_MMA(0, 0, At, B0); PG8_BAR; PG8_SCHED;
            PG8_LDB(B1, 0, 1); PG8_STAGE(PG8_SB(0, 0), b2, voffB);
            PG8_BAR; PG8_WAIT_L(0); PG8_MMA(0, 1, At, B1); PG8_BAR;
            PG8_LDA(At, 0, 1); PG8_STAGE(PG8_SA(0, 0), a2, voffA);
            PG8_BAR; PG8_WAIT_L(0); PG8_MMA(1, 0, At, B0); PG8_BAR; PG8_SCHED;
            PG8_STAGE(PG8_SB(0, 1), b2 + hstepB, voffB);
            PG8_WAIT_V(6); PG8_BAR; PG8_MMA(1, 1, At, B1); PG8_BAR;
            PG8_LDB(B0, 1, 0); PG8_SCHED; PG8_LDA(At, 1, 0); PG8_STAGE(PG8_SA(0, 1), a2 + hstepA, voffA);
            PG8_WAIT_L(8); PG8_BAR; PG8_WAIT_L(0); PG8_MMA(0, 0, At, B0); PG8_BAR; PG8_SCHED;
            PG8_LDB(B1, 1, 1); PG8_STAGE(PG8_SB(1, 0), b3, voffB);
            PG8_BAR; PG8_WAIT_L(0); PG8_MMA(0, 1, At, B1); PG8_BAR;
            PG8_LDA(At, 1, 1); PG8_STAGE(PG8_SA(1, 0), a3, voffA);
            PG8_BAR; PG8_WAIT_L(0); PG8_MMA(1, 0, At, B0); PG8_BAR; PG8_SCHED;
            PG8_STAGE(PG8_SB(1, 1), b3 + hstepB, voffB);
            PG8_WAIT_V(6); PG8_BAR; PG8_MMA(1, 1, At, B1); PG8_BAR;
            }
        }
        if constexpr (ALIGN_EPI) { if (wr == 0) PG8_BAR; }
        if constexpr (!Epi::AFTER_DRAIN) { E(acc, cur, wr, wc, fr, fq); S.done(cur); }
        if (!has_next) break;
#pragma unroll
        for (int a = 0; a < 2; ++a)
#pragma unroll
            for (int b = 0; b < 2; ++b)
#pragma unroll
                for (int m = 0; m < 4; ++m)
#pragma unroll
                    for (int n = 0; n < 2; ++n) acc[a][b][m][n] = (f32x4){0.f, 0.f, 0.f, 0.f};
        cur = nxt; cA = nA; cB = nB; ++ui;
        if constexpr (ALIGN_EPI) { if (wr == 1) PG8_BAR; }
    }
    PG8_WAIT_V(0);
    if constexpr (!ALIGN_EPI) { if (wr == 0) PG8_BAR; }
    PG8_BAR;
    if constexpr (Epi::AFTER_DRAIN) { E.fused(acc, cur, wr, wc, fr, fq, lds, wid, lane); S.done(cur); }
#undef PG8_SA
#undef PG8_SB
#undef PG8_STAGE
#undef PG8_LDA
#undef PG8_LDB
#undef PG8_MMA
#undef PG8_WAIT_V
#undef PG8_WAIT_L
#undef PG8_BAR
#undef PG8_SCHED
}
}
namespace attn {
typedef unsigned short bf16_t;
using bf16x8 = __attribute__((ext_vector_type(8))) short;
using s16x4  = __attribute__((ext_vector_type(4))) short;
using f32x16 = __attribute__((ext_vector_type(16))) float;
using u32x4  = __attribute__((ext_vector_type(4))) unsigned;
constexpr int D = 128, NW = 8, QBLK = 32, KVBLK = 64;
constexpr float SCALE = 0.088388347648318440f;
constexpr float THR = 8.f;
constexpr int SHM_V = KVBLK * D * 2, SHM_K = KVBLK * D * 2, SHM_ATTN = 2 * SHM_V + 2 * SHM_K + NW * 64 * 4;
constexpr int TAB_OFF = SHM_ATTN;
constexpr int LDS_TOTAL = TAB_OFF + 768 * 4;
#define KSWZ(row, colB) ((row) * 256 + ((colB) ^ (((row) & 7) << 4)))
#define SBAR() __builtin_amdgcn_sched_barrier(0)
__device__ __forceinline__ int crow(int r, int hi) { return (r & 3) + 8 * (r >> 2) + 4 * hi; }
__device__ __forceinline__ unsigned cvtpk(float lo, float hi) { unsigned r; asm volatile("v_cvt_pk_bf16_f32 %0, %1, %2" : "=v"(r) : "v"(lo), "v"(hi)); return r; }
__device__ __forceinline__ bf16x8 ld8(const bf16_t* p) { return *reinterpret_cast<const bf16x8*>(p); }

__device__ __forceinline__ void partialSM(f32x16& p0, f32x16& p1, float& m_reg, float& mn, float& alpha) {
  constexpr float C = SCALE * 1.4426950408889634f;
  float pmax = p0[0];
#pragma unroll
  for (int r = 1; r < 16; ++r) pmax = fmaxf(pmax, p0[r]);
#pragma unroll
  for (int r = 0; r < 16; ++r) pmax = fmaxf(pmax, p1[r]);
  { auto rr = __builtin_amdgcn_permlane32_swap(__float_as_uint(pmax), __float_as_uint(pmax), false, false);
    pmax = fmaxf(__uint_as_float(rr[0]), __uint_as_float(rr[1])); }
  if (__builtin_expect(__all(pmax - m_reg <= THR / SCALE), 1)) { mn = m_reg; alpha = 1.f; }
  else { mn = fmaxf(m_reg, pmax); alpha = __builtin_amdgcn_exp2f((m_reg - mn) * C); m_reg = mn; }
  float mnC = -mn * C;
#pragma unroll
  for (int r = 0; r < 16; ++r) p0[r] = fmaf(p0[r], C, mnC);
#pragma unroll
  for (int r = 0; r < 16; ++r) p1[r] = fmaf(p1[r], C, mnC);
#pragma unroll
  for (int r = 0; r < 16; ++r) p0[r] = __builtin_amdgcn_exp2f(p0[r]);
}
__device__ __forceinline__ void finishSM(f32x16& p0, f32x16& p1, float alpha, float& l_reg, bf16x8& pa0, bf16x8& pa1, bf16x8& pa2, bf16x8& pa3) {
#pragma unroll
  for (int r = 0; r < 16; ++r) p1[r] = __builtin_amdgcn_exp2f(p1[r]);
  float ps = 0;
#pragma unroll
  for (int r = 0; r < 16; ++r) ps += p0[r];
#pragma unroll
  for (int r = 0; r < 16; ++r) ps += p1[r];
  { auto rr = __builtin_amdgcn_permlane32_swap(__float_as_uint(ps), __float_as_uint(ps), false, false);
    ps = __uint_as_float(rr[0]) + __uint_as_float(rr[1]); }
  l_reg = l_reg * alpha + ps;
#define PK4(P, BASE, OUT) do { unsigned a0 = cvtpk(P[BASE + 0], P[BASE + 1]), a1 = cvtpk(P[BASE + 2], P[BASE + 3]);   \
    unsigned b0 = cvtpk(P[BASE + 4], P[BASE + 5]), b1 = cvtpk(P[BASE + 6], P[BASE + 7]);                              \
    auto r0 = __builtin_amdgcn_permlane32_swap(a0, b0, false, false); auto r1 = __builtin_amdgcn_permlane32_swap(a1, b1, false, false); \
    u32x4 w = {r0[0], r1[0], r0[1], r1[1]}; OUT = *reinterpret_cast<bf16x8*>(&w); } while (0)
  PK4(p0, 0, pa0); PK4(p0, 8, pa1); PK4(p1, 0, pa2); PK4(p1, 8, pa3);
#undef PK4
}
__device__ __forceinline__ void qkt(f32x16& p0, f32x16& p1, const bf16_t* Ks, const bf16x8* qr, int r32, int hi) {
  p0 = f32x16{}; p1 = f32x16{};
#pragma unroll
  for (int d0 = 0; d0 < 8; ++d0) { int cb = (d0 * 16 + hi * 8) * 2;
    bf16x8 b0 = *reinterpret_cast<const bf16x8*>((const char*)Ks + KSWZ(r32, cb));
    bf16x8 b1 = *reinterpret_cast<const bf16x8*>((const char*)Ks + KSWZ(32 + r32, cb));
    p0 = __builtin_amdgcn_mfma_f32_32x32x16_bf16(b0, qr[d0], p0, 0, 0, 0);
    p1 = __builtin_amdgcn_mfma_f32_32x32x16_bf16(b1, qr[d0], p1, 0, 0, 0); }
}
__device__ __forceinline__ void wmask(f32x16& p0, f32x16& p1, const float* tab, int kb, int qpos, int hi) {
  const float* tp = tab + (kb - qpos + 384 + 4 * hi);
#pragma unroll
  for (int r = 0; r < 16; ++r) { const int c = (r & 3) + 8 * (r >> 2); p0[r] += tp[c]; p1[r] += tp[32 + c];
    if ((r & 3) == 3) { asm volatile("" ::: "memory"); __builtin_amdgcn_sched_barrier(0); } }
}
__device__ __forceinline__ int v_st(int k, int c) { const int kk = (k & ~0xC) | ((k & 4) << 1) | ((k & 8) >> 1); return ((kk >> 3) * 4 + (c >> 5)) * 512 + ((kk & 7) * 32 + (c & 31)) * 2; }
__device__ __forceinline__ int v_rd_base(int lane) { return ((lane & 3) << 3) | (((lane >> 2) & 3) << 6) | (((lane >> 4) & 1) << 5) | (((lane >> 5) & 1) << 8); }
constexpr int v_rd_off(int d0, int ks, int half) { return d0 * 512 + ks * 4096 + half * 2048; }
template <int OFF> __device__ __forceinline__ s16x4 tr_read(int vb) {
  s16x4 r; asm volatile("ds_read_b64_tr_b16 %0, %1 offset:%2" : "=&v"(r) : "v"(vb), "i"(OFF) : "memory"); return r;
}
template <int D0> __device__ __forceinline__ void pv_one(f32x16& od, int vb, bf16x8 pa0, bf16x8 pa1, bf16x8 pa2, bf16x8 pa3) {
  const s16x4 l0 = tr_read<v_rd_off(D0, 0, 0)>(vb), h0 = tr_read<v_rd_off(D0, 0, 1)>(vb), l1 = tr_read<v_rd_off(D0, 1, 0)>(vb), h1 = tr_read<v_rd_off(D0, 1, 1)>(vb);
  const s16x4 l2 = tr_read<v_rd_off(D0, 2, 0)>(vb), h2 = tr_read<v_rd_off(D0, 2, 1)>(vb), l3 = tr_read<v_rd_off(D0, 3, 0)>(vb), h3 = tr_read<v_rd_off(D0, 3, 1)>(vb);
  asm volatile("s_waitcnt lgkmcnt(0)" ::: "memory"); SBAR();
#define PK(L, H) (bf16x8){L[0], L[1], L[2], L[3], H[0], H[1], H[2], H[3]}
  od = __builtin_amdgcn_mfma_f32_32x32x16_bf16(pa0, PK(l0, h0), od, 0, 0, 0);
  od = __builtin_amdgcn_mfma_f32_32x32x16_bf16(pa1, PK(l1, h1), od, 0, 0, 0);
  od = __builtin_amdgcn_mfma_f32_32x32x16_bf16(pa2, PK(l2, h2), od, 0, 0, 0);
  od = __builtin_amdgcn_mfma_f32_32x32x16_bf16(pa3, PK(l3, h3), od, 0, 0, 0);
#undef PK
}
__device__ __forceinline__ void pv_d0(f32x16* o, int vb, bf16x8 pa0, bf16x8 pa1, bf16x8 pa2, bf16x8 pa3) {
  pv_one<0>(o[0], vb, pa0, pa1, pa2, pa3); pv_one<1>(o[1], vb, pa0, pa1, pa2, pa3); pv_one<2>(o[2], vb, pa0, pa1, pa2, pa3); pv_one<3>(o[3], vb, pa0, pa1, pa2, pa3);
}

template <bool WINDOW, int ldq, int ldk, int ldo, int SDEPTH>
__device__ __forceinline__ void attn_unit(const bf16_t* __restrict__ Qb, const bf16_t* __restrict__ Kh, const bf16_t* __restrict__ Vh,
                                          bf16_t* __restrict__ Ob, int NT, int qpos0, int kpos0, float sink, char* lds) {
  int tid = threadIdx.x; asm volatile("" : "+v"(tid));
  const int wid = tid >> 6, lane = tid & 63, r32 = lane & 31, hi = lane >> 5;
  bf16_t* V_lds = (bf16_t*)lds; bf16_t* K_lds = (bf16_t*)(lds + 2 * SHM_V);
  float* ws = (float*)(lds + 2 * SHM_V + 2 * SHM_K) + wid * 64; float* li_l = ws; float* al_l = ws + 32;
  const float* tab = (const float*)(lds + TAB_OFF);
  float m_reg = WINDOW ? sink * (1.0f / SCALE) : -1e30f, l_reg = WINDOW ? 1.0f : 0.0f; f32x16 o[4] = {}; bf16x8 qr[8];
  const int qpos = qpos0 + wid * QBLK + r32;
  const bf16_t* Qw = Qb + (long)(wid * QBLK + r32) * ldq + hi * 8;
#pragma unroll
  for (int d0 = 0; d0 < 8; ++d0) qr[d0] = ld8(Qw + d0 * 16);
  const int sr = tid >> 4, sc = (tid & 15) * 8, vst0 = v_st(sr, sc), vst1 = v_st(32 + sr, sc);
  const int vb0 = (int)(uintptr_t)V_lds + v_rd_base(lane);
  struct { bf16x8 vs0, vs1, ks0, ks1; } sr_[SDEPTH];
#define SLOAD(i, k0) do { sr_[i].vs0 = ld8(&Vh[(long)((k0) + sr) * ldk + sc]); sr_[i].vs1 = ld8(&Vh[(long)((k0) + 32 + sr) * ldk + sc]); \
    sr_[i].ks0 = ld8(&Kh[(long)((k0) + sr) * ldk + sc]); sr_[i].ks1 = ld8(&Kh[(long)((k0) + 32 + sr) * ldk + sc]); } while (0)
#define SWRITE(b, i) do { *(bf16x8*)((char*)V_lds + (b) * SHM_V + vst0) = sr_[i].vs0;          \
    *(bf16x8*)((char*)V_lds + (b) * SHM_V + vst1) = sr_[i].vs1; int kc = sc * 2;               \
    *(bf16x8*)((char*)K_lds + (b) * SHM_K + KSWZ(sr, kc)) = sr_[i].ks0;                       \
    *(bf16x8*)((char*)K_lds + (b) * SHM_K + KSWZ(32 + sr, kc)) = sr_[i].ks1; } while (0)
#define SWAIT() do { if constexpr (SDEPTH == 2) asm volatile("s_waitcnt vmcnt(4)" ::: "memory"); else asm volatile("s_waitcnt vmcnt(0)" ::: "memory"); } while (0)
#define RESC(a) do { if (__any((a) < 1.f)) { if (hi == 0) al_l[r32] = (a); asm volatile("s_waitcnt lgkmcnt(0)" ::: "memory"); \
    _Pragma("unroll") for (int d = 0; d < 4; ++d) _Pragma("unroll") for (int r = 0; r < 16; ++r) o[d][r] *= al_l[crow(r, hi)]; } } while (0)
  f32x16 pA0, pA1, pB0, pB1; float mnA, mnB, alA, alB; bf16x8 pa0, pa1, pa2, pa3;
  constexpr int SE = 0, SO = SDEPTH - 1;
  SLOAD(SE, 0); asm volatile("s_waitcnt vmcnt(0)" ::: "memory"); SWRITE(0, SE); __syncthreads();
  qkt(pA0, pA1, K_lds, qr, r32, hi); if (WINDOW) wmask(pA0, pA1, tab, kpos0, qpos, hi); partialSM(pA0, pA1, m_reg, mnA, alA);
  SLOAD(SO, KVBLK); if constexpr (SDEPTH == 2) { if (2 < NT) SLOAD(SE, 2 * KVBLK); }
  SWAIT(); SWRITE(1, SO); __syncthreads();
  for (int j = 1; j + 1 < NT; j += 2) {
    SBAR(); qkt(pB0, pB1, (bf16_t*)((char*)K_lds + SHM_K), qr, r32, hi); if (WINDOW) wmask(pB0, pB1, tab, kpos0 + j * KVBLK, qpos, hi);
    finishSM(pA0, pA1, alA, l_reg, pa0, pa1, pa2, pa3); SBAR();
    SLOAD(SO, (j + SDEPTH) * KVBLK); SBAR();
    pv_d0(o, vb0, pa0, pa1, pa2, pa3); partialSM(pB0, pB1, m_reg, mnB, alB);
    __syncthreads(); SWAIT(); SWRITE(0, SE);
    RESC(alB); __syncthreads();
    SBAR(); qkt(pA0, pA1, K_lds, qr, r32, hi); if (WINDOW) wmask(pA0, pA1, tab, kpos0 + (j + 1) * KVBLK, qpos, hi);
    finishSM(pB0, pB1, alB, l_reg, pa0, pa1, pa2, pa3); SBAR();
    if (SDEPTH == 1 || j + 3 < NT) SLOAD(SE, (j + 1 + SDEPTH) * KVBLK); SBAR();
    pv_d0(o, vb0 + (int)SHM_V, pa0, pa1, pa2, pa3); partialSM(pA0, pA1, m_reg, mnA, alA);
    __syncthreads(); SWAIT(); SWRITE(1, SO);
    RESC(alA); __syncthreads();
  }
  SBAR(); qkt(pB0, pB1, (bf16_t*)((char*)K_lds + SHM_K), qr, r32, hi); if (WINDOW) wmask(pB0, pB1, tab, kpos0 + (NT - 1) * KVBLK, qpos, hi);
  finishSM(pA0, pA1, alA, l_reg, pa0, pa1, pa2, pa3); SBAR();
  pv_d0(o, vb0, pa0, pa1, pa2, pa3); partialSM(pB0, pB1, m_reg, mnB, alB);
  __syncthreads(); RESC(alB);
  finishSM(pB0, pB1, alB, l_reg, pa0, pa1, pa2, pa3); SBAR();
  pv_d0(o, vb0 + (int)SHM_V, pa0, pa1, pa2, pa3);
  if (hi == 0) li_l[r32] = l_reg; asm volatile("s_waitcnt lgkmcnt(0)" ::: "memory");
  float rli[16];
#pragma unroll
  for (int r = 0; r < 16; ++r) rli[r] = __builtin_amdgcn_rcpf(li_l[crow(r, hi)]);
  bf16_t* Ow = Ob + (long)(wid * QBLK) * ldo;
#pragma unroll
  for (int r = 0; r < 16; ++r) { const int orow = crow(r, hi);
#pragma unroll
    for (int d0 = 0; d0 < 4; ++d0) { const float v = o[d0][r] * rli[r]; Ow[(long)orow * ldo + d0 * 32 + r32] = (bf16_t)(cvtpk(v, v) & 0xffffu); } }
#undef SLOAD
#undef SWRITE
#undef SWAIT
#undef RESC
}
#undef KSWZ
#undef SBAR
}

constexpr int NWAVES = 8, NTHREADS = 512;
constexpr int DM = 2048, SEQ = 4096, NSEQ = 6, MTOK = NSEQ * SEQ  , MEMLEN = 256, MMEM = NSEQ * MEMLEN  , NPROMPT = 4 * SEQ;
constexpr int DEPTH = 4, NNORM = 7;
constexpr int GH = 4096, NGRP = 8;
constexpr int QKVW = 3072, NHEAD = 16;
constexpr int DRNN = 2816, RBD = 176;
constexpr int MEMW = 512, DFF = 5632;
constexpr float EPS = 1e-6f;
enum { I_XP = 0, I_XS, I_MP, I_MS, I_NORMS, I_REL, I_AWIN, I_ALNG, I_ALNB, I_AWS, I_ABS, I_AWOUT, I_BQKV, I_BSINK, I_BWO, I_CWIN, I_CCONVW, I_CCONVB, I_CWA, I_CBA, I_CWX, I_CBX, I_CLAM, I_CWOUT,
       I_MWQ, I_MWKV, I_MWO, I_FGU, I_FDN, N_IN };
constexpr size_t MiB = 1u << 20;
constexpr size_t WS_CTL = 0, CTL_ZERO_BYTES = 1 * MiB;
constexpr size_t WS_W = 1 * MiB;
constexpr size_t W_MQKV = WS_W, W_MO = WS_W + 6 * MiB, W_GU = WS_W + 8 * MiB, W_DN = WS_W + 52 * MiB, W_MIX = WS_W + 74 * MiB;
constexpr size_t W_MIX2 = W_MIX + 32 * MiB;
constexpr size_t W_GATES = W_MIX + 43 * MiB, W_SPL = W_MIX + 49 * MiB;
constexpr size_t WS_XN = 125 * MiB;
constexpr size_t WS_HB = 227 * MiB;
constexpr size_t WS_BIG = 323 * MiB;
constexpr size_t WS_END = WS_BIG + 680 * MiB;
constexpr size_t B_HF = WS_BIG;
constexpr size_t B_U = WS_BIG, B_VT = WS_BIG + 192 * MiB, B_PST = WS_BIG + 384 * MiB;
constexpr size_t B_QKV = WS_BIG, B_OB = WS_BIG + 144 * MiB;
constexpr size_t B_LA = WS_BIG, B_UU = WS_BIG + 264 * MiB, B_GATE = WS_BIG + 528 * MiB, B_RNN = WS_BIG, B_CAR = WS_BIG + 660 * MiB;
constexpr size_t B_XC = WS_XN;
constexpr size_t B_QM = WS_BIG, B_KVM = WS_BIG + 24 * MiB, B_OM = WS_BIG + 28 * MiB;
static_assert(W_GATES + 6 * MiB <= W_SPL && W_SPL + 64 * 1024 <= WS_XN && W_MIX2 + 16 * MiB <= WS_XN, "weight map");
static_assert((size_t)MTOK * 4096 * 2 <= WS_BIG - WS_XN, "XC fits XN|HB");
constexpr int CW_TMO = 0, CW_BAR = 4096;

constexpr int RING_BYTES = 131072, LDSCTL_OFF = RING_BYTES, MISC_OFF = LDSCTL_OFF + 320, LDS_BYTES = 147456;

#define GAS __attribute__((address_space(1)))
#define LAS __attribute__((address_space(3)))
typedef unsigned short bf16;
typedef unsigned v4u __attribute__((ext_vector_type(4)));
typedef unsigned v2u __attribute__((ext_vector_type(2)));
typedef float f32x4 __attribute__((ext_vector_type(4)));
typedef float f32x2 __attribute__((ext_vector_type(2)));
typedef short bf16x8 __attribute__((ext_vector_type(8)));
typedef _Float16 h2 __attribute__((ext_vector_type(2)));
#define LDS_WAIT() asm volatile("s_waitcnt lgkmcnt(0)" ::: "memory")
#define VM_WAIT() asm volatile("s_waitcnt vmcnt(0)" ::: "memory")
__device__ __forceinline__ unsigned f2bf(float f) { unsigned u = __builtin_bit_cast(unsigned, f); return (u + 0x7fffu + ((u >> 16) & 1u)) >> 16; }
__device__ __forceinline__ unsigned pk2(float lo, float hi) { return f2bf(lo) | (f2bf(hi) << 16); }
__device__ __forceinline__ float bflo(unsigned w) { return __uint_as_float(w << 16); }
__device__ __forceinline__ float bfhi(unsigned w) { return __uint_as_float(w & 0xffff0000u); }
__device__ __forceinline__ float ex(float x) { return __builtin_amdgcn_exp2f(1.4426950408889634f * x); }


#define XB_TMO      128
#define XB_XCNT(j)  (256  + 64 * (j))
#define XB_XSUB(j)  (1280 + 64 * (j))
#define XB_XGEN(j)  (2304 + 64 * (j))
#define XB_TOP      3328
#define XB_TOPGEN   3392
#define XCD_BAR_WORDS 3456
#define XB_SPIN_CAP (1u << 18)

__device__ __forceinline__ unsigned xb_ld(unsigned* p)              { return __hip_atomic_load(p, __ATOMIC_RELAXED, __HIP_MEMORY_SCOPE_AGENT); }
__device__ __forceinline__ unsigned xb_add(unsigned* p, unsigned v) { return __hip_atomic_fetch_add(p, v, __ATOMIC_RELAXED, __HIP_MEMORY_SCOPE_AGENT); }
__device__ __forceinline__ unsigned xb_xcc_id() { return (unsigned)__builtin_amdgcn_s_getreg((3 << 11) | 20) & 0xFu; }
#define XB_SPIN(cond, bar) do { unsigned _sp = 0; while (cond) { __builtin_amdgcn_s_sleep(1); \
    if ((++_sp & 255u) == 0u) { if (xb_ld(&(bar)[XB_TMO])) break; if (_sp > XB_SPIN_CAP) { atomicAdd(&(bar)[XB_TMO], 1u); break; } } } } while (0)

struct XcdBarrier {
    unsigned* bar; unsigned x;
    volatile LAS unsigned* st;
};

__device__ __forceinline__ XcdBarrier xcd_barrier_post(unsigned* bar, volatile LAS unsigned* st) {
    XcdBarrier b; b.bar = bar; b.x = xb_xcc_id(); b.st = st;
    if (threadIdx.x == 0) (void)xb_add(&bar[XB_XCNT(b.x)], 1u);
    return b;
}
__device__ __forceinline__ void xcd_barrier_complete(unsigned* bar, unsigned x, unsigned& nloc, unsigned& nx) {
    const unsigned G = gridDim.x * gridDim.y * gridDim.z;
    unsigned sum, cnt, mine, sp = 0u;
    for (;;) {
        sum = 0u; cnt = 0u; mine = 0u;
#pragma unroll
        for (unsigned j = 0; j < 16; ++j) { const unsigned c = xb_ld(&bar[XB_XCNT(j)]); sum += c; cnt += (c > 0u) ? 1u : 0u; mine = (j == x) ? c : mine; }
        if (sum == G) break;
        __builtin_amdgcn_s_sleep(1);
        if ((++sp & 255u) == 0u) { if (xb_ld(&bar[XB_TMO])) break; if (sp > XB_SPIN_CAP) { atomicAdd(&bar[XB_TMO], 1u); break; } }
    }
    nloc = mine > 0u ? mine : 1u; nx = cnt > 0u ? cnt : 1u;
}

__device__ __forceinline__ void xcd_barrier(const XcdBarrier& b) {
    asm volatile("s_waitcnt vmcnt(0)" ::: "memory");
    __syncthreads();
    if (threadIdx.x == 0) {
        unsigned* bar = b.bar;
        __builtin_amdgcn_s_waitcnt(0);
        unsigned nloc = b.st[0], nx = b.st[1];
        if (nloc == 0u) { xcd_barrier_complete(bar, b.x, nloc, nx); b.st[0] = nloc; b.st[1] = nx; }
        const unsigned old = xb_add(&bar[XB_XSUB(b.x)], 1u);
        const unsigned gen = old / nloc;
        if (old + 1u == (gen + 1u) * nloc) {
            __builtin_amdgcn_fence(__ATOMIC_RELEASE, "agent");
            asm volatile("s_waitcnt vmcnt(0)" ::: "memory");
            const unsigned og = xb_add(&bar[XB_TOP], 1u);
            const unsigned tg = og / nx;
            if (og + 1u == (tg + 1u) * nx) xb_add(&bar[XB_TOPGEN], 1u);
            else XB_SPIN(xb_ld(&bar[XB_TOPGEN]) == tg, bar);
            __builtin_amdgcn_fence(__ATOMIC_ACQUIRE, "agent");
            xb_add(&bar[XB_XGEN(b.x)], 1u);
            asm volatile("s_waitcnt vmcnt(0)" ::: "memory");
        } else {
            XB_SPIN(xb_ld(&bar[XB_XGEN(b.x)]) == gen, bar);
            __builtin_amdgcn_fence(__ATOMIC_ACQUIRE, "agent");
            asm volatile("s_waitcnt vmcnt(0)" ::: "memory");
        }
    }
    __syncthreads();
}
__device__ __forceinline__ float wave_sum(float v) {
#pragma unroll
    for (int o = 1; o < 64; o <<= 1) v += __shfl_xor(v, o);
    return v;
}
__device__ __forceinline__ void conv_job(const float* __restrict__ W, int K, int N, bf16* __restrict__ WT, int maptype, LAS float* scr, int gw, int NGW, int lane) {
    const int nblk = N / 32, nitems = (K / 64) * nblk;
    for (int it = gw; it < nitems; it += NGW) {
        const int kb = it / nblk, nb = it - kb * nblk, k0 = 64 * kb, n0 = 32 * nb;
        int drow0 = n0;
        if (maptype == 1) { const int half = N >> 1; const int nn = n0 < half ? n0 : n0 - half; drow0 = (nn >> 7) * 256 + (nn & 127) + (n0 < half ? 0 : 128); }
#pragma unroll 8
        for (int i = 0; i < 32; ++i) { const int kk = 2 * i + (lane >> 5); scr[kk * 33 + (lane & 31)] = W[(size_t)(k0 + kk) * N + n0 + (lane & 31)]; }
        LDS_WAIT(); asm volatile("" ::: "memory");
        const int c = lane & 7;
#pragma unroll
        for (int j = 0; j < 4; ++j) { const int n = (lane >> 3) + 8 * j; const LAS float* s = scr + (8 * c) * 33 + n;
            v4u o; o.x = pk2(s[0 * 33], s[1 * 33]); o.y = pk2(s[2 * 33], s[3 * 33]); o.z = pk2(s[4 * 33], s[5 * 33]); o.w = pk2(s[6 * 33], s[7 * 33]);
            *(v4u*)(WT + (size_t)(drow0 + n) * K + k0 + 8 * c) = o; }
        LDS_WAIT(); asm volatile("" ::: "memory");
    }
}
__device__ __forceinline__ void gates_job(const float* __restrict__ wa, const float* __restrict__ wx, bf16* __restrict__ GW, int gt, int NGT) {
    for (int it = gt; it < 16 * 768 * 32; it += NGT) {
        const int k8 = it & 31, row = (it >> 5) % 768, h = it / (768 * 32);
        const int j = row >> 8, bj = (row >> 7) & 1, cs = row & 127, s = j * 128 + cs;
        float v[8];
#pragma unroll
        for (int e = 0; e < 8; ++e) v[e] = 0.f;
        if (s < 352) { const int d = s >= 176 ? 1 : 0, cb = s - 176 * d; const float* src = (bj ? wx : wa) + ((size_t)(d * 16 + h) * 176) * 176 + cb;
#pragma unroll
            for (int e = 0; e < 8; ++e) { const int k = 8 * k8 + e; if (k < 176) v[e] = src[(size_t)k * 176]; } }
        v4u o; o.x = pk2(v[0], v[1]); o.y = pk2(v[2], v[3]); o.z = pk2(v[4], v[5]); o.w = pk2(v[6], v[7]);
        *(v4u*)(GW + ((size_t)(h * 768 + row) * 256 + 8 * k8)) = o;
    }
}

template <int MODE>
__device__ __forceinline__ void norm_pass(const float* __restrict__ xp, const float* __restrict__ xs, GAS float* __restrict__ X, const bf16* __restrict__ Hb,
                                          const float* __restrict__ g_post, const float* __restrict__ g_pre, bf16* __restrict__ XN, int gw, int NGW, int lane) {
    for (int row = gw; row < MTOK; row += NGW) {
        const GAS float* xin = MODE == 0 ? (const GAS float*)(row < NPROMPT ? xp + (size_t)row * DM : xs + (size_t)(row - NPROMPT) * DM) : (const GAS float*)(X + (size_t)row * DM);
        f32x4 x[8];
#pragma unroll
        for (int j = 0; j < 8; ++j) x[j] = ((const GAS f32x4*)xin)[lane + 64 * j];
        if (MODE != 0) {
            v2u hw[8];
#pragma unroll
            for (int j = 0; j < 8; ++j) hw[j] = ((const v2u*)(Hb + (size_t)row * DM))[lane + 64 * j];
            float ss = 0.f;
#pragma unroll
            for (int j = 0; j < 8; ++j) { const float a = bflo(hw[j].x), b = bfhi(hw[j].x), c = bflo(hw[j].y), d = bfhi(hw[j].y); ss += (a * a + b * b) + (c * c + d * d); }
            const float rstd = rsqrtf(wave_sum(ss) * (1.0f / DM) + EPS);
#pragma unroll
            for (int j = 0; j < 8; ++j) { const f32x4 g = ((const f32x4*)g_post)[lane + 64 * j];
                x[j].x += bflo(hw[j].x) * rstd * g.x; x[j].y += bfhi(hw[j].x) * rstd * g.y; x[j].z += bflo(hw[j].y) * rstd * g.z; x[j].w += bfhi(hw[j].y) * rstd * g.w; }
        }
#pragma unroll
        for (int j = 0; j < 8; ++j) ((GAS f32x4*)(X + (size_t)row * DM))[lane + 64 * j] = x[j];
        if (MODE != 2) {
            float s2 = 0.f;
#pragma unroll
            for (int j = 0; j < 8; ++j) s2 += (x[j].x * x[j].x + x[j].y * x[j].y) + (x[j].z * x[j].z + x[j].w * x[j].w);
            const float r2 = rsqrtf(wave_sum(s2) * (1.0f / DM) + EPS);
#pragma unroll
            for (int j = 0; j < 8; ++j) { const f32x4 g = ((const f32x4*)g_pre)[lane + 64 * j];
                v2u o; o.x = pk2(x[j].x * r2 * g.x, x[j].y * r2 * g.y); o.y = pk2(x[j].z * r2 * g.z, x[j].w * r2 * g.w);
                ((v2u*)(XN + (size_t)row * DM))[lane + 64 * j] = o; }
        }
    }
}
__device__ __forceinline__ void mem_norm(const float* __restrict__ mp, const float* __restrict__ ms, const float* __restrict__ g, bf16* __restrict__ XN, int gw, int NGW, int lane) {
    for (int r = gw; r < MMEM; r += NGW) {
        const float* xin = r < 4 * MEMLEN ? mp + (size_t)r * DM : ms + (size_t)(r - 4 * MEMLEN) * DM;
        f32x4 x[8]; float s2 = 0.f;
#pragma unroll
        for (int j = 0; j < 8; ++j) { x[j] = ((const f32x4*)xin)[lane + 64 * j]; s2 += (x[j].x * x[j].x + x[j].y * x[j].y) + (x[j].z * x[j].z + x[j].w * x[j].w); }
        const float r2 = rsqrtf(wave_sum(s2) * (1.0f / DM) + EPS);
#pragma unroll
        for (int j = 0; j < 8; ++j) { const f32x4 gg = ((const f32x4*)g)[lane + 64 * j];
            v2u o; o.x = pk2(x[j].x * r2 * gg.x, x[j].y * r2 * gg.y); o.y = pk2(x[j].z * r2 * gg.z, x[j].w * r2 * gg.w);
            ((v2u*)(XN + (size_t)(MTOK + r) * DM))[lane + 64 * j] = o; }
    }
}

__device__ __forceinline__ void sgu_unit(int n, int g, const bf16* __restrict__ VT, const f32x2* __restrict__ PST, bf16* __restrict__ U, const float* __restrict__ Ws  ,
                                         const float* __restrict__ bs  , const float* __restrict__ lng, const float* __restrict__ lnb, LAS unsigned char* lds, int tid, int lane, int wave) {
    constexpr int WROW = 272;
    LAS unsigned char* WSP = lds; LAS float* MU = (LAS float*)(lds + 128 * WROW); LAS float* RS = MU + 128; LAS float* K1 = RS + 128; LAS float* K2 = K1 + 128; LAS float* BSL = K2 + 128;
    __syncthreads();
    {
        const int tk = tid >> 2, part = tid & 3; float s = 0.f, q = 0.f;
        const f32x2* p = PST + (size_t)(128 * n + tk) * 32 + part * 8;
#pragma unroll
        for (int i = 0; i < 8; ++i) { const f32x2 v = p[i]; s += v.x; q += v.y; }
        s += __shfl_xor(s, 1); q += __shfl_xor(q, 1); s += __shfl_xor(s, 2); q += __shfl_xor(q, 2);
        if (part == 0) { const float mean = s * (1.0f / GH); const float var = fmaxf(q * (1.0f / GH) - mean * mean, 0.f); MU[tk] = mean; RS[tk] = rsqrtf(var + EPS); }
    }
    __syncthreads();
    {
        const int p = tid >> 2, part = tid & 3; float k1 = 0.f, k2 = 0.f;
        const f32x4* wrow = (const f32x4*)(Ws + p * 128 + part * 32);
#pragma unroll
        for (int i = 0; i < 8; ++i) { const f32x4 w = wrow[i]; const int q0 = part * 32 + 4 * i;
            const float r0 = RS[q0], r1 = RS[q0 + 1], r2 = RS[q0 + 2], r3 = RS[q0 + 3];
            const float a = w.x * r0, b = w.y * r1, c = w.z * r2, d = w.w * r3;
            k1 += (a * MU[q0] + b * MU[q0 + 1]) + (c * MU[q0 + 2] + d * MU[q0 + 3]); k2 += (w.x + w.y) + (w.z + w.w);
            v2u o; o.x = pk2(a, b); o.y = pk2(c, d); *(LAS v2u*)(WSP + p * WROW + q0 * 2) = o; }
        k1 += __shfl_xor(k1, 1); k2 += __shfl_xor(k2, 1); k1 += __shfl_xor(k1, 2); k2 += __shfl_xor(k2, 2);
        if (part == 0) { K1[p] = k1; K2[p] = k2; BSL[p] = bs[p]; }
    }
    __syncthreads();
    const int fr = lane & 15, fq = lane >> 4, cbase = 512 * g + 64 * wave;
    bf16x8 a[4][4];
#pragma unroll
    for (int ci = 0; ci < 4; ++ci)
#pragma unroll
        for (int ks = 0; ks < 4; ++ks) a[ci][ks] = *(const bf16x8*)(VT + (size_t)(cbase + 16 * ci + fr) * MTOK + 128 * n + 32 * ks + 8 * fq);
    f32x4 lg[4], lb[4];
#pragma unroll
    for (int ci = 0; ci < 4; ++ci) { lg[ci] = *(const f32x4*)(lng + cbase + 16 * ci + 4 * fq); lb[ci] = *(const f32x4*)(lnb + cbase + 16 * ci + 4 * fq); }
#pragma unroll 1
    for (int pi = 0; pi < 8; ++pi) {
        bf16x8 b[4];
#pragma unroll
        for (int ks = 0; ks < 4; ++ks) b[ks] = *(const LAS bf16x8*)(WSP + (16 * pi + fr) * WROW + (32 * ks + 8 * fq) * 2);
        const int p = 16 * pi + fr; const float k1p = K1[p], k2p = K2[p], bsp = BSL[p];
        f32x4 acc[4];
#pragma unroll
        for (int ci = 0; ci < 4; ++ci) acc[ci] = (f32x4){0.f, 0.f, 0.f, 0.f};
#pragma unroll
        for (int ks = 0; ks < 4; ++ks)
#pragma unroll
            for (int ci = 0; ci < 4; ++ci) acc[ci] = __builtin_amdgcn_mfma_f32_16x16x32_bf16(a[ci][ks], b[ks], acc[ci], 0, 0, 0);
        bf16* urow = U + (size_t)(128 * n + p) * GH + cbase + 4 * fq;
#pragma unroll
        for (int ci = 0; ci < 4; ++ci) { const v2u uw = *(const v2u*)(urow + 16 * ci);
            const float v0 = lg[ci].x * (acc[ci].x - k1p) + lb[ci].x * k2p + bsp, v1 = lg[ci].y * (acc[ci].y - k1p) + lb[ci].y * k2p + bsp;
            const float v2 = lg[ci].z * (acc[ci].z - k1p) + lb[ci].z * k2p + bsp, v3 = lg[ci].w * (acc[ci].w - k1p) + lb[ci].w * k2p + bsp;
            v2u o; o.x = pk2(bflo(uw.x) * v0, bfhi(uw.x) * v1); o.y = pk2(bflo(uw.y) * v2, bfhi(uw.y) * v3);
            *(v2u*)(urow + 16 * ci) = o; }
    }
}

__device__ __forceinline__ void conv_phase(const bf16* __restrict__ RNN, const float* __restrict__ cw  , const float* __restrict__ cb, bf16* __restrict__ XC, int gt, int NGT) {
    for (long it = gt; it < (long)MTOK * 512; it += NGT) {
        const int s = (int)(it & 511), t = (int)(it >> 9), h = s >> 5, j = s & 31;
        v4u o = (v4u){0u, 0u, 0u, 0u};
        if (j < 22) {
            const int ch = h * 176 + 8 * j, tl = t & (SEQ - 1);
            float acc[8];
            { const f32x4 b0 = *(const f32x4*)(cb + ch), b1 = *(const f32x4*)(cb + ch + 4); acc[0] = b0.x; acc[1] = b0.y; acc[2] = b0.z; acc[3] = b0.w; acc[4] = b1.x; acc[5] = b1.y; acc[6] = b1.z; acc[7] = b1.w; }
#pragma unroll
            for (int k = 0; k < 4; ++k) { const int tt = tl + k - 2;
                if (tt >= 0 && tt < SEQ) { const v4u xw = *(const v4u*)(RNN + (size_t)(t + k - 2) * DRNN + ch);
                    const f32x4 w0 = *(const f32x4*)(cw + k * DRNN + ch), w1 = *(const f32x4*)(cw + k * DRNN + ch + 4);
                    acc[0] += bflo(xw.x) * w0.x; acc[1] += bfhi(xw.x) * w0.y; acc[2] += bflo(xw.y) * w0.z; acc[3] += bfhi(xw.y) * w0.w;
                    acc[4] += bflo(xw.z) * w1.x; acc[5] += bfhi(xw.z) * w1.y; acc[6] += bflo(xw.w) * w1.z; acc[7] += bfhi(xw.w) * w1.w; } }
            o.x = pk2(acc[0], acc[1]); o.y = pk2(acc[2], acc[3]); o.z = pk2(acc[4], acc[5]); o.w = pk2(acc[6], acc[7]);
        }
        *(v4u*)(XC + (size_t)t * 4096 + s * 8) = o;
    }
}
__device__ __forceinline__ void scan1_phase(_Float16* __restrict__ LA, _Float16* __restrict__ UU, float* __restrict__ CT, float* __restrict__ HE, int gw, int NGW, int lane) {
    for (int it = gw; it < NSEQ * 2 * 64 * 22; it += NGW) {
        const int cg = it % 22, ck = (it / 22) & 63, d = (it / (22 * 64)) & 1, b = it / (22 * 64 * 2);
        const int ch = 128 * cg + 2 * lane, t0 = b * SEQ + ck * 64;
        const size_t dbase = (size_t)d * MTOK * DRNN;
        float c0 = 0.f, c1 = 0.f, h0 = 0.f, h1 = 0.f;
#pragma unroll 1
        for (int sb = 0; sb < 64; sb += 16) {
            h2 la[16], uu[16];
#pragma unroll
            for (int s = 0; s < 16; ++s) { const int t = d == 0 ? t0 + sb + s : t0 + 63 - (sb + s); const size_t o = dbase + (size_t)t * DRNN + ch;
                la[s] = *(const h2*)(LA + o); uu[s] = *(const h2*)(UU + o); }
#pragma unroll
            for (int s = 0; s < 16; ++s) { const int t = d == 0 ? t0 + sb + s : t0 + 63 - (sb + s); const size_t o = dbase + (size_t)t * DRNN + ch;
                const float l0 = (float)la[s].x, l1 = (float)la[s].y;
                c0 += l0; c1 += l1; h0 = ex(l0) * h0 + (float)uu[s].x; h1 = ex(l1) * h1 + (float)uu[s].y;
                h2 co, ho; co.x = (_Float16)c0; co.y = (_Float16)c1; ho.x = (_Float16)h0; ho.y = (_Float16)h1;
                *(h2*)(LA + o) = co; *(h2*)(UU + o) = ho; }
        }
        const int cs = d == 0 ? ck : 63 - ck;
        const size_t co = ((size_t)((b * 2 + d) * 64 + cs)) * DRNN + ch;
        *(f32x2*)(CT + co) = (f32x2){c0, c1}; *(f32x2*)(HE + co) = (f32x2){h0, h1};
    }
}
__device__ __forceinline__ void scan2_phase(const _Float16* __restrict__ LA, const _Float16* __restrict__ UU, const float* __restrict__ CT, const float* __restrict__ HE, bf16* __restrict__ GATE, int gw, int NGW, int lane) {
    for (int it = gw; it < NSEQ * 64 * 22; it += NGW) {
        const int cg = it % 22, ck = (it / 22) & 63, b = it / (22 * 64);
        const int ch = 128 * cg + 2 * lane, t0 = b * SEQ + ck * 64;
        float hin[2][2];
#pragma unroll
        for (int d = 0; d < 2; ++d) { const int cs = d == 0 ? ck : 63 - ck; float a0 = 0.f, a1 = 0.f;
            const size_t cb = ((size_t)((b * 2 + d) * 64)) * DRNN + ch;
            for (int c = 0; c < cs; ++c) { const f32x2 ct = *(const f32x2*)(CT + cb + (size_t)c * DRNN), he = *(const f32x2*)(HE + cb + (size_t)c * DRNN);
                a0 = ex(ct.x) * a0 + he.x; a1 = ex(ct.y) * a1 + he.y; }
            hin[d][0] = a0; hin[d][1] = a1; }
        const size_t d1 = (size_t)MTOK * DRNN;
#pragma unroll 4
        for (int s = 0; s < 64; ++s) { const size_t o = (size_t)(t0 + s) * DRNN + ch;
            const h2 lf = *(const h2*)(LA + o), uf = *(const h2*)(UU + o), lb = *(const h2*)(LA + d1 + o), ub = *(const h2*)(UU + d1 + o);
            const unsigned gwd = *(const unsigned*)(GATE + o);
            const float y0 = ((float)uf.x + ex((float)lf.x) * hin[0][0]) + ((float)ub.x + ex((float)lb.x) * hin[1][0]);
            const float y1 = ((float)uf.y + ex((float)lf.y) * hin[0][1]) + ((float)ub.y + ex((float)lb.y) * hin[1][1]);
            *(unsigned*)(GATE + o) = pk2(bflo(gwd) * y0, bfhi(gwd) * y1); }
    }
}

#ifndef MK_SITES
#define MK_SITES 0xFFFF
#endif
struct Args { const float* in[N_IN]; float* out; unsigned char* ws; int ph_lo, ph_hi; };
static_assert(sizeof(Args) == (N_IN + 2) * 8 + 8, "Args has no padding");

__device__ __forceinline__ bool slot_active(int kind, int slot) { return slot <= 2 || (slot >= 3 && slot <= 5 && kind == 2) || (slot >= 6 && slot <= 14); }

__global__ void __launch_bounds__(NTHREADS, 2) fwd(Args args) {
    extern __shared__ __attribute__((aligned(16))) unsigned char lds_raw[];
    LAS unsigned char* lds = (LAS unsigned char*)lds_raw;
    for (int u = threadIdx.x; u < (LDS_BYTES - LDSCTL_OFF) / 4; u += NTHREADS) ((LAS unsigned*)(lds + LDSCTL_OFF))[u] = 0u;
    __syncthreads();
    const int lo = args.ph_lo, hi = args.ph_hi;
    const bool fused = (hi - lo) > 1;
    XcdBarrier bar; bar.bar = (unsigned*)(args.ws + WS_CTL) + CW_BAR; bar.x = 0; bar.st = nullptr;
    if (fused) bar = xcd_barrier_post((unsigned*)(args.ws + WS_CTL) + CW_BAR, (volatile LAS unsigned*)(lds + MISC_OFF) + 8);
#ifndef MK_KINDS
#define MK_KINDS 7
#endif
#define KIND_ON(k) (((MK_KINDS) >> (k)) & 1)
#define INS(s) ((((MK_SITES) >> (s)) & 1) && lo <= P0 + (s) && P0 + (s) < hi)
#define SEAMS(s) do { if (fused && P0 + (s) + 1 < hi) xcd_barrier(bar); } while (0)

#pragma unroll 1
    for (int L = 0; L < DEPTH; ++L) {
        unsigned char* ws_l = args.ws; asm volatile("" : "+s"(ws_l));
        GAS unsigned char* const ws = (GAS unsigned char*)ws_l;
        int tid = threadIdx.x; asm volatile("" : "+v"(tid));
        int bid = blockIdx.x, G = gridDim.x; asm volatile("" : "+s"(bid), "+s"(G));
        asm volatile("" : "+s"(bar.x));
        const int lane = tid & 63, wave = __builtin_amdgcn_readfirstlane(tid >> 6);
        const int gw = bid * NWAVES + wave, NGW = G * NWAVES, gt = bid * NTHREADS + tid, NGT = G * NTHREADS;
        bf16* const XN = (bf16*)(ws + WS_XN); bf16* const HB = (bf16*)(ws + WS_HB);
        float* X_l = args.out; asm volatile("" : "+s"(X_l));
        GAS float* const X = (GAS float*)X_l;
        const float* norms = args.in[I_NORMS];
        const int kind = L % 3, jl = L / 3, P0 = L * 16;
        const float* gN = norms + (size_t)L * NNORM * DM;
        if (INS(0)) {
            LAS float* scr = (LAS float*)(lds + wave * 8448);
            conv_job(args.in[I_MWQ] + (size_t)L * DM * MEMW, DM, MEMW, (bf16*)(ws + W_MQKV), 0, scr, gw, NGW, lane);
            conv_job(args.in[I_MWKV] + (size_t)L * DM * 2 * MEMW, DM, 2 * MEMW, (bf16*)(ws + W_MQKV) + (size_t)MEMW * DM, 0, scr, gw, NGW, lane);
            conv_job(args.in[I_MWO] + (size_t)L * MEMW * DM, MEMW, DM, (bf16*)(ws + W_MO), 0, scr, gw, NGW, lane);
            conv_job(args.in[I_FGU] + (size_t)L * DM * 2 * DFF, DM, 2 * DFF, (bf16*)(ws + W_GU), 1, scr, gw, NGW, lane);
            conv_job(args.in[I_FDN] + (size_t)L * DFF * DM, DFF, DM, (bf16*)(ws + W_DN), 0, scr, gw, NGW, lane);
            if (kind == 0) {
                conv_job(args.in[I_AWIN] + (size_t)jl * DM * 2 * GH, DM, 2 * GH, (bf16*)(ws + W_MIX), 0, scr, gw, NGW, lane);
                conv_job(args.in[I_AWOUT] + (size_t)jl * GH * DM, GH, DM, (bf16*)(ws + W_MIX2), 0, scr, gw, NGW, lane);
            } else if (kind == 1) {
                conv_job(args.in[I_BQKV], DM, QKVW, (bf16*)(ws + W_MIX), 0, scr, gw, NGW, lane);
                conv_job(args.in[I_BWO], DM, DM, (bf16*)(ws + W_MIX2), 0, scr, gw, NGW, lane);
            } else {
                conv_job(args.in[I_CWIN], DM, 2 * DRNN, (bf16*)(ws + W_MIX), 0, scr, gw, NGW, lane);
                conv_job(args.in[I_CWOUT], DRNN, DM, (bf16*)(ws + W_MIX2), 0, scr, gw, NGW, lane);
                gates_job(args.in[I_CWA], args.in[I_CWX], (bf16*)(ws + W_GATES), gt, NGT);
                for (int i = gt; i < 2 * DRNN; i += NGT) { const float xl = -args.in[I_CLAM][i]; ((float*)(ws + W_SPL))[i] = 8.0f * (fmaxf(xl, 0.f) + log1pf(expf(-fabsf(xl)))); }
            }
            if (L == 0) norm_pass<0>(args.in[I_XP], args.in[I_XS], X, nullptr, nullptr, gN, XN, gw, NGW, lane);
            SEAMS(0);
        }
        if (INS(1)) {
            {
                const int nN = kind == 0 ? 16 : (kind == 1 ? 12 : 22);
                pg8::Gemm g{XN, (const bf16*)(ws + W_MIX), DM, DM, DM};
                pg8::StaticOrder S; S.init(96, nN, G, bid, DM, DM);
                pg8::EpiGen E;
                if (kind == 0)      E = pg8::EpiGen{(bf16*)(ws + B_U), GH, 1, nullptr, 0, 0, 1 << 30, 0};
                else if (kind == 1) E = pg8::EpiGen{(bf16*)(ws + B_QKV), QKVW, 0, nullptr, 0, 0, 1 << 30, 0};
                else                E = pg8::EpiGen{(bf16*)(ws + B_GATE), DRNN, 1, (bf16*)(ws + B_RNN), DRNN, 0, 11, 0};
                pg8::gemm_phase<pg8::EpiGen, pg8::StaticOrder, true, true>(lds, g, S, E);
            }
            if (kind == 0) {
                __syncthreads();
                pg8::Gemm g{(const bf16*)(ws + W_MIX) + (size_t)GH * DM, XN, DM, DM, DM};
                pg8::StaticOrder S; S.init(16, 96, G, bid, DM, DM);
                pg8::EpiGeluStatsT E{(bf16*)(ws + B_VT), MTOK, (pg8::f32x2*)(ws + B_PST)};
                pg8::gemm_phase<pg8::EpiGeluStatsT, pg8::StaticOrder, true, true>(lds, g, S, E);
            }
            SEAMS(1);
        }
        if (INS(2)) {
            if (KIND_ON(0) && kind == 0) {
                const float* Wsp = args.in[I_AWS] + (size_t)jl * NGRP * 128 * 128; const float* bsp = args.in[I_ABS] + (size_t)jl * NGRP * 128;
                for (int u = bid; u < 192 * NGRP; u += G) { const int n = u >> 3, g = u & 7;
                    sgu_unit(n, g, (const bf16*)(ws + B_VT), (const f32x2*)(ws + B_PST), (bf16*)(ws + B_U), Wsp + (size_t)g * 16384, bsp + g * 128,
                             args.in[I_ALNG] + (size_t)jl * GH, args.in[I_ALNB] + (size_t)jl * GH, lds, tid, lane, wave); }
            } else if (KIND_ON(1) && kind == 1) {
                const bf16* QKV = (const bf16*)(ws + B_QKV); bf16* OB = (bf16*)(ws + B_OB);
                LAS float* tab = (LAS float*)(lds + attn::TAB_OFF);
                for (int u = bid; u < NSEQ * 16 * NHEAD; u += G) { const int h = u & 15, qt = (u >> 4) & 15, b = u >> 8;
                    __syncthreads();
                    for (int idx = tid; idx < 768; idx += NTHREADS) { const int rel = idx - 384, n = rel < 0 ? -rel : rel;
                        const int bk = n < 8 ? n : 8 + (n >= 12) + (n >= 16) + (n >= 23) + (n >= 32) + (n >= 46) + (n >= 64) + (n >= 91);
                        tab[idx] = n <= 128 ? args.in[I_REL][((rel > 0 ? 16 : 0) + bk) * NHEAD + h] * (1.0f / attn::SCALE) : -1e30f; }
                    const int klo = qt * 256 - 128 < 0 ? 0 : qt * 256 - 128, khi = qt * 256 + 384 > SEQ ? SEQ : qt * 256 + 384;
                    const size_t row0 = (size_t)b * SEQ + qt * 256, krow0 = (size_t)b * SEQ + klo; const int kv = h >> 2;
                    attn::attn_unit<true, QKVW, QKVW, DM, 1>(QKV + row0 * QKVW + h * 128, QKV + krow0 * QKVW + 2048 + kv * 128, QKV + krow0 * QKVW + 2560 + kv * 128,
                                          OB + row0 * DM + h * 128, (khi - klo) / 64, qt * 256, klo, args.in[I_BSINK][h], (char*)lds_raw);
                }
            } else if (KIND_ON(2)) {
                conv_phase((const bf16*)(ws + B_RNN), args.in[I_CCONVW], args.in[I_CCONVB], (bf16*)(ws + B_XC), gt, NGT);
            }
            SEAMS(2);
        }
        if (kind == 2) {
            if (INS(3)) {
                pg8::Gemm g{(const bf16*)(ws + B_XC), (const bf16*)(ws + W_GATES), 4096, 256, 256};
                pg8::GateOrder S{G, bid};
                pg8::EpiLRU E{(_Float16*)(ws + B_LA), (_Float16*)(ws + B_UU), (const bf16*)(ws + B_XC), args.in[I_CBA], args.in[I_CBX], (const float*)(ws + W_SPL), (unsigned)(MTOK * DRNN)};
                pg8::gemm_phase<pg8::EpiLRU, pg8::GateOrder, true, true>(lds, g, S, E);
                SEAMS(3);
            }
            if (INS(4)) { scan1_phase((_Float16*)(ws + B_LA), (_Float16*)(ws + B_UU), (float*)(ws + B_CAR), (float*)(ws + B_CAR) + (size_t)NSEQ * 2 * 64 * DRNN, gw, NGW, lane); SEAMS(4); }
            if (INS(5)) { scan2_phase((const _Float16*)(ws + B_LA), (const _Float16*)(ws + B_UU), (const float*)(ws + B_CAR), (const float*)(ws + B_CAR) + (size_t)NSEQ * 2 * 64 * DRNN, (bf16*)(ws + B_GATE), gw, NGW, lane); SEAMS(5); }
        }
        if (INS(6)) {
            const bf16* A = kind == 0 ? (const bf16*)(ws + B_U) : (kind == 1 ? (const bf16*)(ws + B_OB) : (const bf16*)(ws + B_GATE));
            const int K = kind == 0 ? GH : (kind == 1 ? DM : DRNN);
            pg8::Gemm g{A, (const bf16*)(ws + W_MIX2), K, K, K};
            pg8::StaticOrder S; S.init(96, 8, G, bid, K, K);
            pg8::EpiGen E{HB, DM, 0, nullptr, 0, 0, 1 << 30, 0};
            pg8::gemm_phase<pg8::EpiGen, pg8::StaticOrder, true, true>(lds, g, S, E);
            SEAMS(6);
        }
        if (INS(7)) {
            norm_pass<1>(nullptr, nullptr, X, HB, gN + 1 * DM, gN + 2 * DM, XN, gw, NGW, lane);
            mem_norm(args.in[I_MP], args.in[I_MS], gN + 4 * DM, XN, gw, NGW, lane);
            SEAMS(7);
        }
        if (INS(8)) {
            pg8::Gemm g{XN, (const bf16*)(ws + W_MQKV), DM, DM, DM};
            pg8::MemProjOrder S{G, bid, (size_t)256 * DM * 2, (size_t)256 * DM * 2};
            pg8::EpiGen E{(bf16*)(ws + B_QM), MEMW, 0, (bf16*)(ws + B_KVM), 2 * MEMW, 0, 2, 96};
            pg8::gemm_phase<pg8::EpiGen, pg8::MemProjOrder, true, true>(lds, g, S, E);
            SEAMS(8);
        }
        if (INS(9)) {
            const bf16* QM = (const bf16*)(ws + B_QM); const bf16* KVM = (const bf16*)(ws + B_KVM); bf16* OM = (bf16*)(ws + B_OM);
            for (int u = bid; u < 96 * 4; u += G) { const int h = u & 3, pm = u >> 2, b = pm >> 4;
                __syncthreads();
                attn::attn_unit<false, MEMW, 2 * MEMW, MEMW, 2>(QM + (size_t)pm * 256 * MEMW + h * 128, KVM + (size_t)b * MEMLEN * 2 * MEMW + h * 128, KVM + (size_t)b * MEMLEN * 2 * MEMW + MEMW + h * 128,
                                       OM + (size_t)pm * 256 * MEMW + h * 128, 4, 0, 0, 0.f, (char*)lds_raw);
            }
            SEAMS(9);
        }
        if (INS(10)) {
            pg8::Gemm g{(const bf16*)(ws + B_OM), (const bf16*)(ws + W_MO), MEMW, MEMW, MEMW};
            pg8::StaticOrder S; S.init(96, 8, G, bid, MEMW, MEMW);
            pg8::EpiGen E{HB, DM, 0, nullptr, 0, 0, 1 << 30, 0};
            pg8::gemm_phase<pg8::EpiGen, pg8::StaticOrder, true, true>(lds, g, S, E);
            SEAMS(10);
        }
        if (INS(11)) { norm_pass<1>(nullptr, nullptr, X, HB, gN + 3 * DM, gN + 5 * DM, XN, gw, NGW, lane); SEAMS(11); }
        if (INS(12)) {
            pg8::Gemm g{XN, (const bf16*)(ws + W_GU), DM, DM, DM};
            pg8::StaticOrder S; S.init(96, 44, G, bid, DM, DM);
            pg8::EpiSwiGLU E{(bf16*)(ws + B_HF), DFF};
            pg8::gemm_phase<pg8::EpiSwiGLU, pg8::StaticOrder, true, true>(lds, g, S, E);
            SEAMS(12);
        }
        if (INS(13)) {
            pg8::Gemm g{(const bf16*)(ws + B_HF), (const bf16*)(ws + W_DN), DFF, DFF, DFF};
            pg8::StaticOrder S; S.init(96, 8, G, bid, DFF, DFF);
            pg8::EpiGen E{HB, DM, 0, nullptr, 0, 0, 1 << 30, 0};
            pg8::gemm_phase<pg8::EpiGen, pg8::StaticOrder, true, true>(lds, g, S, E);
            SEAMS(13);
        }
        if (INS(14)) {
            if (L + 1 < DEPTH) norm_pass<1>(nullptr, nullptr, X, HB, gN + 6 * DM, gN + NNORM * DM, XN, gw, NGW, lane);
            else               norm_pass<2>(nullptr, nullptr, X, HB, gN + 6 * DM, nullptr, nullptr, gw, NGW, lane);
            SEAMS(14);
        }
    }
#undef INS
#undef SEAMS
}

extern "C" void kernel_launch(void* const* d_in, const int* in_sizes, int n_in, void* d_out, int out_size, void* d_ws, size_t ws_size, hipStream_t stream) {
    static int grid = 0;
    if (grid == 0) {
        if (n_in != N_IN || in_sizes[0] != NPROMPT * DM || out_size != MTOK * DM || ws_size < WS_END) {
            fprintf(stderr, "kernel_launch: unexpected shapes: n_in %d in0 %d out %d ws %zu (need %zu); nothing launched\n", n_in, n_in > 0 ? in_sizes[0] : -1, out_size, ws_size, (size_t)WS_END); grid = -1; return; }
        int dev = 0, cus = 0, per_cu = 0;
        if (hipGetDevice(&dev) != hipSuccess || hipDeviceGetAttribute(&cus, hipDeviceAttributeMultiprocessorCount, dev) != hipSuccess) { fprintf(stderr, "kernel_launch: device query failed\n"); grid = -1; return; }
        if (hipFuncSetAttribute((const void*)fwd, hipFuncAttributeMaxDynamicSharedMemorySize, LDS_BYTES) != hipSuccess) { fprintf(stderr, "kernel_launch: hipFuncSetAttribute failed\n"); grid = -1; return; }
        if (hipOccupancyMaxActiveBlocksPerMultiprocessor(&per_cu, (const void*)fwd, NTHREADS, LDS_BYTES) != hipSuccess || per_cu < 1)
            fprintf(stderr, "kernel_launch: note: occupancy query reports %d workgroups per CU\n", per_cu);
        (void)hipGetLastError();
        grid = cus;
    }
    if (grid < 0) return;
    if (hipMemsetAsync((char*)d_ws + WS_CTL, 0, CTL_ZERO_BYTES, stream) != hipSuccess) { fprintf(stderr, "kernel_launch: memset failed\n"); return; }
    Args a{};
    for (int i = 0; i < N_IN; ++i) a.in[i] = (const float*)d_in[i];
    a.out = (float*)d_out; a.ws = (unsigned char*)d_ws;
#if MK_MULTI
    for (int L = 0; L < DEPTH; ++L)
        for (int s = 0; s < 15; ++s) {
            const int kind = L % 3;
            if (!(s <= 2 || (s >= 3 && s <= 5 && kind == 2) || s >= 6)) continue;
            a.ph_lo = L * 16 + s; a.ph_hi = a.ph_lo + 1;
            hipLaunchKernelGGL(fwd, dim3(grid), dim3(NTHREADS), LDS_BYTES, stream, a);
        }
#else
    a.ph_lo = 0; a.ph_hi = DEPTH * 16;
    hipLaunchKernelGGL(fwd, dim3(grid), dim3(NTHREADS), LDS_BYTES, stream, a);
#endif
    const hipError_t le = hipPeekAtLastError();
    if (le != hipSuccess) fprintf(stderr, "kernel_launch: launch failed: %s\n", hipGetErrorName(le));
}
```

```cpp
#include <hip/hip_runtime.h>
#include <cstdio>
#include <cstdint>

#ifndef MK_MULTI
#define MK_MULTI 0
#endif

namespace pg8 {
#define PG8_LAS __attribute__((address_space(3)))
typedef unsigned short bf16_t;
typedef short bf16x8 __attribute__((ext_vector_type(8)));
typedef float f32x4 __attribute__((ext_vector_type(4)));
typedef float f32x2 __attribute__((ext_vector_type(2)));
typedef unsigned u32x4 __attribute__((ext_vector_type(4)));
typedef unsigned u32x2 __attribute__((ext_vector_type(2)));
typedef _Float16 f16x4 __attribute__((ext_vector_type(4)));
constexpr int BM = 256, BK = 64, HALF = 128, HTB = HALF * BK * 2  , STAGE_BYTES = 8 * HTB, NXCD = 8, WGM = 8;

__host__ __device__ __forceinline__ int lds_byte(int r, int c) { const int st = (r >> 4) * 2 + (c >> 5), rr = r & 15, cc = c & 31, ob = rr * 64 + cc * 2; return st * 1024 + (ob ^ (((ob >> 9) & 1) << 5)); }
__host__ __device__ __forceinline__ void stage_rc(int b, int& R, int& C) { const int st = b / 1024, sb = b % 1024, swz = sb ^ (((sb >> 9) & 1) << 5); R = (st >> 1) * 16 + swz / 64; C = (st & 1) * 32 + (swz % 64) / 2; }
__host__ __device__ __forceinline__ int perm32(int rho) { const int n = rho >> 4, i = rho & 15; return 8 * (i >> 2) + 4 * n + (i & 3); }

struct Unit { int pm, pn; };
struct Gemm { const bf16_t* A; const bf16_t* Bt; int lda, ldb, K; };

struct StaticOrder {
    int nM, nN, nwg, G, c; size_t tA, tB;
    __device__ void init(int nM_, int nN_, int G_, int c_, int lda, int ldb) { nM = nM_; nN = nN_; nwg = nM * nN; G = G_; c = c_; tA = (size_t)BM * lda * 2; tB = (size_t)BM * ldb * 2; }
    __device__ bool next(int i, Unit& u) const {
        const long L = (long)i * G + c; if (L >= nwg) return false;
        int wgid = (int)L; { const int q = nwg / NXCD, r = nwg % NXCD, xcd = wgid % NXCD, off = wgid / NXCD; wgid = (xcd < r ? xcd * (q + 1) : r * (q + 1) + (xcd - r) * q) + off; }
        const int nig = WGM * nN, gid = wgid / nig, fm = gid * WGM, gsz = (nM - fm) < WGM ? (nM - fm) : WGM;
        u.pm = fm + ((wgid % nig) % gsz); u.pn = (wgid % nig) / gsz; return true;
    }
    __device__ __forceinline__ size_t offA(const Unit& u) const { return (size_t)u.pm * tA; }
    __device__ __forceinline__ size_t offB(const Unit& u) const { return (size_t)u.pn * tB; }
    __device__ __forceinline__ void a_ready(const Unit&) const {}
    __device__ __forceinline__ void done(const Unit&) const {}
};
struct MemProjOrder {
    int G, c; size_t tA, tB;
    __device__ bool next(int i, Unit& u) const {
        const int L = i * G + c; if (L >= 216) return false;
        if (L < 192) { u.pm = L >> 1; u.pn = L & 1; } else { const int r = L - 192; u.pm = 96 + (r >> 2); u.pn = 2 + (r & 3); }
        return true;
    }
    __device__ __forceinline__ size_t offA(const Unit& u) const { return (size_t)u.pm * tA; }
    __device__ __forceinline__ size_t offB(const Unit& u) const { return (size_t)u.pn * tB; }
    __device__ __forceinline__ void a_ready(const Unit&) const {}
    __device__ __forceinline__ void done(const Unit&) const {}
};
struct GateOrder {
    int G, c;
    __device__ bool next(int i, Unit& u) const {
        const int L = i * G + c; if (L >= 96 * 48) return false;
        u.pm = L / 48; u.pn = L % 48; return true;
    }
    __device__ __forceinline__ size_t offA(const Unit& u) const { return (size_t)u.pm * (256 * 4096 * 2) + (size_t)(u.pn / 3) * 512; }
    __device__ __forceinline__ size_t offB(const Unit& u) const { return (size_t)u.pn * (256 * 256 * 2); }
    __device__ __forceinline__ void a_ready(const Unit&) const {}
    __device__ __forceinline__ void done(const Unit&) const {}
};

__device__ __forceinline__ unsigned cvt_pk_bf16(float lo, float hi) { unsigned r; asm volatile("v_cvt_pk_bf16_f32 %0, %1, %2" : "=v"(r) : "v"(lo), "v"(hi)); return r; }
__device__ __forceinline__ float bf_lo(unsigned w) { return __uint_as_float(w << 16); }
__device__ __forceinline__ float bf_hi(unsigned w) { return __uint_as_float(w & 0xffff0000u); }
__device__ __forceinline__ float sigmoid_f(float x) { return __builtin_amdgcn_rcpf(1.0f + __builtin_amdgcn_exp2f(-1.4426950408889634f * x)); }
__device__ __forceinline__ float gelu_f(float x) { const float t = x * (1.0f + 0.044715f * x * x); return x * __builtin_amdgcn_rcpf(1.0f + __builtin_amdgcn_exp2f(-2.3022081981f * t)); }
__device__ __forceinline__ float silu_f(float x) { return x * sigmoid_f(x); }

struct EpiGen {
    static constexpr bool PERM = true, AFTER_DRAIN = false;
    bf16_t* O0; int ldc0, act0; bf16_t* O1; int ldc1, act1; int pn_split, pm_split;
    __device__ __forceinline__ void operator()(const f32x4 (&acc)[2][2][4][2], const Unit& u, int wr, int wc, int fr, int fq) const {
        const bool v1 = u.pn >= pn_split;
        bf16_t* base = v1 ? O1 : O0; const int ldc = v1 ? ldc1 : ldc0, act = v1 ? act1 : act0;
        const int row0 = (v1 ? u.pm - pm_split : u.pm) * BM + wr * 64 + fr, col0 = (v1 ? u.pn - pn_split : u.pn) * BM + wc * 32 + 8 * fq;
#pragma unroll
        for (int ai = 0; ai < 2; ++ai)
#pragma unroll
            for (int m = 0; m < 4; ++m) { bf16_t* rowp = base + (size_t)(row0 + ai * HALF + m * 16) * ldc + col0;
#pragma unroll
                for (int bj = 0; bj < 2; ++bj) { f32x4 v0 = acc[ai][bj][m][0], v1v = acc[ai][bj][m][1];
                    if (act == 1) {
#pragma unroll
                        for (int e = 0; e < 4; ++e) { v0[e] = gelu_f(v0[e]); v1v[e] = gelu_f(v1v[e]); } }
                    u32x4 w; w.x = cvt_pk_bf16(v0[0], v0[1]); w.y = cvt_pk_bf16(v0[2], v0[3]); w.z = cvt_pk_bf16(v1v[0], v1v[1]); w.w = cvt_pk_bf16(v1v[2], v1v[3]);
                    *(u32x4*)(rowp + bj * HALF) = w; } }
    }
};
struct EpiGeluStatsT {
    static constexpr bool PERM = true, AFTER_DRAIN = false;
    bf16_t* O; int ldc; f32x2* pst;
    __device__ __forceinline__ void operator()(const f32x4 (&acc)[2][2][4][2], const Unit& u, int wr, int wc, int fr, int fq) const {
        const int row0 = u.pm * BM + wr * 64 + fr, col0 = u.pn * BM + wc * 32 + 8 * fq;
        f32x4 s[2][2], q[2][2];
#pragma unroll
        for (int bj = 0; bj < 2; ++bj)
#pragma unroll
            for (int n = 0; n < 2; ++n) { s[bj][n] = (f32x4){0.f, 0.f, 0.f, 0.f}; q[bj][n] = (f32x4){0.f, 0.f, 0.f, 0.f}; }
#pragma unroll
        for (int ai = 0; ai < 2; ++ai)
#pragma unroll
            for (int m = 0; m < 4; ++m) { bf16_t* rowp = O + (size_t)(row0 + ai * HALF + m * 16) * ldc + col0;
#pragma unroll
                for (int bj = 0; bj < 2; ++bj) { f32x4 v0 = acc[ai][bj][m][0], v1v = acc[ai][bj][m][1];
#pragma unroll
                    for (int e = 0; e < 4; ++e) { v0[e] = gelu_f(v0[e]); v1v[e] = gelu_f(v1v[e]); }
                    s[bj][0] += v0; s[bj][1] += v1v; q[bj][0] += v0 * v0; q[bj][1] += v1v * v1v;
                    u32x4 w; w.x = cvt_pk_bf16(v0[0], v0[1]); w.y = cvt_pk_bf16(v0[2], v0[3]); w.z = cvt_pk_bf16(v1v[0], v1v[1]); w.w = cvt_pk_bf16(v1v[2], v1v[3]);
                    *(u32x4*)(rowp + bj * HALF) = w; } }
#pragma unroll
        for (int bj = 0; bj < 2; ++bj)
#pragma unroll
            for (int n = 0; n < 2; ++n)
#pragma unroll
                for (int e = 0; e < 4; ++e) { float a = s[bj][n][e], b = q[bj][n][e];
#pragma unroll
                    for (int o = 1; o < 16; o <<= 1) { a += __shfl_xor(a, o); b += __shfl_xor(b, o); }
                    s[bj][n][e] = a; q[bj][n][e] = b; }
        if (fr == 0) {
            const int slot = u.pm * 2 + wr;
#pragma unroll
            for (int bj = 0; bj < 2; ++bj)
#pragma unroll
                for (int n = 0; n < 2; ++n)
#pragma unroll
                    for (int e = 0; e < 4; ++e) pst[(size_t)(col0 + bj * HALF + 4 * n + e) * 32 + slot] = (f32x2){s[bj][n][e], q[bj][n][e]};
        }
    }
};
struct EpiSwiGLU {
    static constexpr bool PERM = true, AFTER_DRAIN = false;
    bf16_t* O; int ldc;
    __device__ __forceinline__ void operator()(const f32x4 (&acc)[2][2][4][2], const Unit& u, int wr, int wc, int fr, int fq) const {
        const int row0 = u.pm * BM + wr * 64 + fr, col0 = u.pn * HALF + wc * 32 + 8 * fq;
#pragma unroll
        for (int ai = 0; ai < 2; ++ai)
#pragma unroll
            for (int m = 0; m < 4; ++m) { bf16_t* rowp = O + (size_t)(row0 + ai * HALF + m * 16) * ldc + col0;
                f32x4 v0, v1v;
#pragma unroll
                for (int e = 0; e < 4; ++e) { v0[e] = silu_f(acc[ai][0][m][0][e]) * acc[ai][1][m][0][e]; v1v[e] = silu_f(acc[ai][0][m][1][e]) * acc[ai][1][m][1][e]; }
                u32x4 w; w.x = cvt_pk_bf16(v0[0], v0[1]); w.y = cvt_pk_bf16(v0[2], v0[3]); w.z = cvt_pk_bf16(v1v[0], v1v[1]); w.w = cvt_pk_bf16(v1v[2], v1v[3]);
                *(u32x4*)rowp = w; }
    }
};
struct EpiLRU {
    static constexpr bool PERM = false, AFTER_DRAIN = false;
    _Float16* LA; _Float16* UU; const bf16_t* XC; const float* b_a; const float* b_x; const float* spl8; unsigned dstride;
    __device__ __forceinline__ void operator()(const f32x4 (&acc)[2][2][4][2], const Unit& u, int wr, int wc, int fr, int fq_) const {
        int fq = fq_; const int h = u.pn / 3, j = u.pn - 3 * h;
        int row0 = u.pm * BM + wr * 64 + fr;
        asm volatile("" : "+v"(row0), "+v"(fq));
#pragma unroll
        for (int n = 0; n < 2; ++n) {
            const int s0 = j * 128 + wc * 32 + 16 * n + 4 * fq;
            if (s0 < 352) {
                const int d = s0 >= 176 ? 1 : 0, cb = s0 - 176 * d, ch = h * 176 + cb;
                const f32x4 ba = *(const f32x4*)(b_a + d * 2816 + ch), bx = *(const f32x4*)(b_x + d * 2816 + ch), sp = *(const f32x4*)(spl8 + d * 2816 + ch);
                const unsigned obase = (unsigned)d * dstride + (unsigned)ch, xbase = (unsigned)(h * 256 + cb);
#pragma unroll
                for (int ai = 0; ai < 2; ++ai)
#pragma unroll
                    for (int m = 0; m < 4; ++m) { const unsigned row = (unsigned)(row0 + ai * HALF + m * 16);
                        const u32x2 xw = *(const u32x2*)(XC + (row * 4096u + xbase));
                        const float xv[4] = {bf_lo(xw.x), bf_hi(xw.x), bf_lo(xw.y), bf_hi(xw.y)};
                        f16x4 la, uu;
#pragma unroll
                        for (int e = 0; e < 4; ++e) {
                            const float r = sigmoid_f(acc[ai][0][m][n][e] + ba[e]), gi = sigmoid_f(acc[ai][1][m][n][e] + bx[e]);
                            const float l = -sp[e] * r, x2 = 2.0f * l;
                            const float om = x2 > -0.05f ? -x2 * (1.0f + x2 * (0.5f + x2 * (0.16666667f + x2 * 0.041666668f))) : 1.0f - __builtin_amdgcn_exp2f(1.4426950408889634f * x2);
                            la[e] = (_Float16)l; uu[e] = (_Float16)(__builtin_sqrtf(om) * gi * xv[e]);
                        }
                        const unsigned o = obase + row * 2816u;
                        *(f16x4*)(LA + o) = la; *(f16x4*)(UU + o) = uu; asm volatile("" ::: "memory"); }
            }
        }
    }
};

template <class Epi, class Sched, bool ALIGN_EPI = false, bool SP2 = false>
__device__ __forceinline__ void gemm_phase(PG8_LAS unsigned char* lds, const Gemm g, const Sched& S, const Epi& E) {
    int tid = threadIdx.x; asm volatile("" : "+v"(tid));
    const int wid = __builtin_amdgcn_readfirstlane(tid >> 6), lane = tid & 63, wr = wid >> 2, wc = wid & 3, fr = lane & 15, fq = lane >> 4;
    int K = g.K; asm volatile("" : "+s"(K));
    const int nt = K / BK;
    unsigned voffA[2], voffB[2];
#pragma unroll
    for (int i = 0; i < 2; ++i) { int R, C; stage_rc(tid * 16 + i * 8192, R, C); const int Rb = Epi::PERM ? ((R & ~31) + perm32(R & 31)) : R;
        voffA[i] = (unsigned)(R * g.lda + C) * 2u; voffB[i] = (unsigned)(Rb * g.ldb + C) * 2u; }
    const size_t kstep = (size_t)(BK * 2);
    const size_t hstepA = (size_t)HALF * g.lda * 2, hstepB = (size_t)HALF * g.ldb * 2;
    const unsigned ldsw = (unsigned)wid * 1024u;
    const int aoff = lds_byte(wr * 64 + fr, fq * 8), boff = lds_byte(wc * 32 + fr, fq * 8);
#define PG8_SA(b, h) (((b) * 2 + (h)) * HTB)
#define PG8_SB(b, h) ((4 + (b) * 2 + (h)) * HTB)
#define PG8_STAGE(bufoff, gbase, voff) do { _Pragma("unroll") for (int _i = 0; _i < 2; ++_i) \
        __builtin_amdgcn_global_load_lds((const unsigned*)((const char*)(gbase) + (voff)[_i]), (PG8_LAS unsigned*)(lds + (bufoff) + ldsw + _i * 8192), 16, 0, 0); } while (0)
#define PG8_LDA(dst, b, h) do { _Pragma("unroll") for (int m = 0; m < 4; ++m) _Pragma("unroll") for (int k = 0; k < 2; ++k) dst[m][k] = *(const PG8_LAS bf16x8*)(lds + PG8_SA(b, h) + aoff + m * 2048 + k * 1024); } while (0)
#define PG8_LDB(dst, b, h) do { _Pragma("unroll") for (int n = 0; n < 2; ++n) _Pragma("unroll") for (int k = 0; k < 2; ++k) dst[n][k] = *(const PG8_LAS bf16x8*)(lds + PG8_SB(b, h) + boff + n * 2048 + k * 1024); } while (0)
#define PG8_MMA(ai, bj, At, Bt) do { __builtin_amdgcn_s_setprio(1); _Pragma("unroll") for (int m = 0; m < 4; ++m) _Pragma("unroll") for (int n = 0; n < 2; ++n) _Pragma("unroll") for (int k = 0; k < 2; ++k) \
        acc[ai][bj][m][n] = __builtin_amdgcn_mfma_f32_16x16x32_bf16(Bt[n][k], At[m][k], acc[ai][bj][m][n], 0, 0, 0); __builtin_amdgcn_s_setprio(0); } while (0)
#define PG8_WAIT_V(n) asm volatile("s_waitcnt vmcnt(" #n ")" ::: "memory")
#define PG8_WAIT_L(n) asm volatile("s_waitcnt lgkmcnt(" #n ")" ::: "memory")
#define PG8_BAR __builtin_amdgcn_s_barrier()
#define PG8_SCHED __builtin_amdgcn_sched_barrier(0)
    Unit cur, nxt; int ui = 0;
    if (!S.next(0, cur)) return;
    f32x4 acc[2][2][4][2];
#pragma unroll
    for (int a = 0; a < 2; ++a)
#pragma unroll
        for (int b = 0; b < 2; ++b)
#pragma unroll
            for (int m = 0; m < 4; ++m)
#pragma unroll
                for (int n = 0; n < 2; ++n) acc[a][b][m][n] = (f32x4){0.f, 0.f, 0.f, 0.f};
    bf16x8 At[4][2], B0[2][2], B1[2][2];
    const char* cA = (const char*)g.A + S.offA(cur); const char* cB = (const char*)g.Bt + S.offB(cur);
    S.a_ready(cur);
    if constexpr (SP2) {
        PG8_STAGE(PG8_SB(0, 0), cB, voffB); PG8_STAGE(PG8_SB(0, 1), cB + hstepB, voffB); PG8_STAGE(PG8_SA(0, 0), cA, voffA); PG8_STAGE(PG8_SA(0, 1), cA + hstepA, voffA);
        if (wr == 1) PG8_BAR;
        PG8_WAIT_V(2); PG8_BAR;
        PG8_STAGE(PG8_SB(1, 0), cB + kstep, voffB); PG8_STAGE(PG8_SA(1, 0), cA + kstep, voffA); PG8_STAGE(PG8_SB(1, 1), cB + hstepB + kstep, voffB);
        PG8_WAIT_V(6); PG8_BAR;
    } else {
        PG8_STAGE(PG8_SB(0, 0), cB, voffB); PG8_STAGE(PG8_SA(0, 0), cA, voffA); PG8_STAGE(PG8_SB(0, 1), cB + hstepB, voffB); PG8_STAGE(PG8_SA(0, 1), cA + hstepA, voffA);
        if (wr == 1) PG8_BAR;
        PG8_WAIT_V(4); PG8_BAR;
        PG8_STAGE(PG8_SB(1, 0), cB + kstep, voffB); PG8_STAGE(PG8_SA(1, 0), cA + kstep, voffA); PG8_STAGE(PG8_SB(1, 1), cB + hstepB + kstep, voffB);
        PG8_WAIT_V(6); PG8_BAR;
    }
    for (;;) {
        const bool has_next = S.next(ui + 1, nxt);
        const char* nA = has_next ? (const char*)g.A + S.offA(nxt) : cA; const char* nB = has_next ? (const char*)g.Bt + S.offB(nxt) : cB;
        for (int t = 0; t < nt; t += 2) {
            const bool last = (t == nt - 2);
            const char* a1 = cA + (size_t)(t + 1) * kstep;
            const char* a2 = last ? nA : cA + (size_t)(t + 2) * kstep; const char* b2 = last ? nB : cB + (size_t)(t + 2) * kstep;
            const char* a3 = a2 + kstep; const char* b3 = b2 + kstep;
            if (last && has_next) S.a_ready(nxt);
            if constexpr (SP2) {
            PG8_LDB(B0, 0, 0); PG8_LDB(B1, 0, 1); PG8_SCHED; PG8_LDA(At, 0, 0); PG8_STAGE(PG8_SA(1, 1), a1 + hstepA, voffA);
            PG8_WAIT_V(8); PG8_WAIT_L(0); PG8_BAR; PG8_MMA(0, 0, At, B0); PG8_MMA(0, 1, At, B1); PG8_BAR; PG8_SCHED;
            PG8_LDA(At, 0, 1); PG8_STAGE(PG8_SB(0, 0), b2, voffB); PG8_STAGE(PG8_SB(0, 1), b2 + hstepB, voffB); PG8_STAGE(PG8_SA(0, 0), a2, voffA);
            PG8_WAIT_V(8); PG8_WAIT_L(0); PG8_BAR; PG8_MMA(1, 0, At, B0); PG8_MMA(1, 1, At, B1); PG8_BAR; PG8_SCHED;
            PG8_LDB(B0, 1, 0); PG8_LDB(B1, 1, 1); PG8_SCHED; PG8_LDA(At, 1, 0); PG8_STAGE(PG8_SA(0, 1), a2 + hstepA, voffA);
            PG8_WAIT_V(8); PG8_WAIT_L(0); PG8_BAR; PG8_MMA(0, 0, At, B0); PG8_MMA(0, 1, At, B1); PG8_BAR; PG8_SCHED;
            PG8_LDA(At, 1, 1); PG8_STAGE(PG8_SB(1, 0), b3, voffB); PG8_STAGE(PG8_SB(1, 1), b3 + hstepB, voffB); PG8_STAGE(PG8_SA(1, 0), a3, voffA);
            PG8_WAIT_V(8); PG8_WAIT_L(0); PG8_BAR; PG8_MMA(1, 0, At, B0); PG8_MMA(1, 1, At, B1); PG8_BAR; PG8_SCHED;
            } else {
            PG8_LDB(B0, 0, 0); PG8_SCHED; PG8_LDA(At, 0, 0); PG8_STAGE(PG8_SA(1, 1), a1 + hstepA, voffA);
            PG8_WAIT_L(8); PG8_BAR; PG8_WAIT_L(0); PG8_MMA(0, 0, At, B0); PG8_BAR; PG8_SCHED;
            PG8_LDB(B1, 0, 1); PG8_STAGE(PG8_SB(0, 0), b2, voffB);
            PG8_BAR; PG8_WAIT_L(0); PG8_MMA(0, 1, At, B1); PG8_BAR;
            PG8_LDA(At, 0, 1); PG8_STAGE(PG8_SA(0, 0), a2, voffA);
            PG8_BAR; PG8_WAIT_L(0); PG8_MMA(1, 0, At, B0); PG8_BAR; PG8_SCHED;
            PG8_STAGE(PG8_SB(0, 1), b2 + hstepB, voffB);
            PG8_WAIT_V(6); PG8_BAR; PG8_MMA(1, 1, At, B1); PG8_BAR;
            PG8_LDB(B0, 1, 0); PG8_SCHED; PG8_LDA(At, 1, 0); PG8_STAGE(PG8_SA(0, 1), a2 + hstepA, voffA);
            PG8_WAIT_L(8); PG8_BAR; PG8_WAIT_L(0); PG8_MMA(0, 0, At, B0); PG8_BAR; PG8_SCHED;
            PG8_LDB(B1, 1, 1); PG8_STAGE(PG8_SB(1, 0), b3, voffB);
            PG8_BAR; PG8_WAIT_L(0); PG8_MMA(0, 1, At, B1); PG8_BAR;
            PG8_LDA(At, 1, 1); PG8_STAGE(PG8_SA(1, 0), a3, voffA);
            PG8_BAR; PG8_WAIT_L(0); PG8_MMA(1, 0, At, B0); PG8_BAR; PG8_SCHED;
            PG8_STAGE(PG8_SB(1, 1), b3 + hstepB, voffB);
            PG8_WAIT_V(6); PG8_BAR; PG8_MMA(1, 1, At, B1); PG8_BAR;
            }
        }
        if constexpr (ALIGN_EPI) { if (wr == 0) PG8_BAR; }
        if constexpr (!Epi::AFTER_DRAIN) { E(acc, cur, wr, wc, fr, fq); S.done(cur); }
        if (!has_next) break;
#pragma unroll
        for (int a = 0; a < 2; ++a)
#pragma unroll
            for (int b = 0; b < 2; ++b)
#pragma unroll
                for (int m = 0; m < 4; ++m)
#pragma unroll
                    for (int n = 0; n < 2; ++n) acc[a][b][m][n] = (f32x4){0.f, 0.f, 0.f, 0.f};
        cur = nxt; cA = nA; cB = nB; ++ui;
        if constexpr (ALIGN_EPI) { if (wr == 1) PG8_BAR; }
    }
    PG8_WAIT_V(0);
    if constexpr (!ALIGN_EPI) { if (wr == 0) PG8_BAR; }
    PG8_BAR;
    if constexpr (Epi::AFTER_DRAIN) { E.fused(acc, cur, wr, wc, fr, fq, lds, wid, lane); S.done(cur); }
#undef PG8_SA
#undef PG8_SB
#undef PG8_STAGE
#undef PG8_LDA
#undef PG8_LDB
#undef PG8_MMA
#undef PG8_WAIT_V
#undef PG8_WAIT_L
#undef PG8_BAR
#undef PG8_SCHED
}
}
namespace attn {
typedef unsigned short bf16_t;
using bf16x8 = __attribute__((ext_vector_type(8))) short;
using s16x4  = __attribute__((ext_vector_type(4))) short;
using f32x16 = __attribute__((ext_vector_type(16))) float;
using u32x4  = __attribute__((ext_vector_type(4))) unsigned;
constexpr int D = 128, NW = 8, QBLK = 32, KVBLK = 64;
constexpr float SCALE = 0.088388347648318440f;
constexpr float THR = 8.f;
constexpr int SHM_V = KVBLK * D * 2, SHM_K = KVBLK * D * 2, SHM_ATTN = 2 * SHM_V + 2 * SHM_K + NW * 64 * 4;
constexpr int TAB_OFF = SHM_ATTN;
constexpr int LDS_TOTAL = TAB_OFF + 768 * 4;
#define KSWZ(row, colB) ((row) * 256 + ((colB) ^ (((row) & 7) << 4)))
#define SBAR() __builtin_amdgcn_sched_barrier(0)
__device__ __forceinline__ int crow(int r, int hi) { return (r & 3) + 8 * (r >> 2) + 4 * hi; }
__device__ __forceinline__ unsigned cvtpk(float lo, float hi) { unsigned r; asm volatile("v_cvt_pk_bf16_f32 %0, %1, %2" : "=v"(r) : "v"(lo), "v"(hi)); return r; }
__device__ __forceinline__ bf16x8 ld8(const bf16_t* p) { return *reinterpret_cast<const bf16x8*>(p); }

__device__ __forceinline__ void partialSM(f32x16& p0, f32x16& p1, float& m_reg, float& mn, float& alpha) {
  constexpr float C = SCALE * 1.4426950408889634f;
  float pmax = p0[0];
#pragma unroll
  for (int r = 1; r < 16; ++r) pmax = fmaxf(pmax, p0[r]);
#pragma unroll
  for (int r = 0; r < 16; ++r) pmax = fmaxf(pmax, p1[r]);
  { auto rr = __builtin_amdgcn_permlane32_swap(__float_as_uint(pmax), __float_as_uint(pmax), false, false);
    pmax = fmaxf(__uint_as_float(rr[0]), __uint_as_float(rr[1])); }
  if (__builtin_expect(__all(pmax - m_reg <= THR / SCALE), 1)) { mn = m_reg; alpha = 1.f; }
  else { mn = fmaxf(m_reg, pmax); alpha = __builtin_amdgcn_exp2f((m_reg - mn) * C); m_reg = mn; }
  float mnC = -mn * C;
#pragma unroll
  for (int r = 0; r < 16; ++r) p0[r] = fmaf(p0[r], C, mnC);
#pragma unroll
  for (int r = 0; r < 16; ++r) p1[r] = fmaf(p1[r], C, mnC);
#pragma unroll
  for (int r = 0; r < 16; ++r) p0[r] = __builtin_amdgcn_exp2f(p0[r]);
}
__device__ __forceinline__ void finishSM(f32x16& p0, f32x16& p1, float alpha, float& l_reg, bf16x8& pa0, bf16x8& pa1, bf16x8& pa2, bf16x8& pa3) {
#pragma unroll
  for (int r = 0; r < 16; ++r) p1[r] = __builtin_amdgcn_exp2f(p1[r]);
  float ps = 0;
#pragma unroll
  for (int r = 0; r < 16; ++r) ps += p0[r];
#pragma unroll
  for (int r = 0; r < 16; ++r) ps += p1[r];
  { auto rr = __builtin_amdgcn_permlane32_swap(__float_as_uint(ps), __float_as_uint(ps), false, false);
    ps = __uint_as_float(rr[0]) + __uint_as_float(rr[1]); }
  l_reg = l_reg * alpha + ps;
#define PK4(P, BASE, OUT) do { unsigned a0 = cvtpk(P[BASE + 0], P[BASE + 1]), a1 = cvtpk(P[BASE + 2], P[BASE + 3]);   \
    unsigned b0 = cvtpk(P[BASE + 4], P[BASE + 5]), b1 = cvtpk(P[BASE + 6], P[BASE + 7]);                              \
    auto r0 = __builtin_amdgcn_permlane32_swap(a0, b0, false, false); auto r1 = __builtin_amdgcn_permlane32_swap(a1, b1, false, false); \
    u32x4 w = {r0[0], r1[0], r0[1], r1[1]}; OUT = *reinterpret_cast<bf16x8*>(&w); } while (0)
  PK4(p0, 0, pa0); PK4(p0, 8, pa1); PK4(p1, 0, pa2); PK4(p1, 8, pa3);
#undef PK4
}
__device__ __forceinline__ void qkt(f32x16& p0, f32x16& p1, const bf16_t* Ks, const bf16x8* qr, int r32, int hi) {
  p0 = f32x16{}; p1 = f32x16{};
#pragma unroll
  for (int d0 = 0; d0 < 8; ++d0) { int cb = (d0 * 16 + hi * 8) * 2;
    bf16x8 b0 = *reinterpret_cast<const bf16x8*>((const char*)Ks + KSWZ(r32, cb));
    bf16x8 b1 = *reinterpret_cast<const bf16x8*>((const char*)Ks + KSWZ(32 + r32, cb));
    p0 = __builtin_amdgcn_mfma_f32_32x32x16_bf16(b0, qr[d0], p0, 0, 0, 0);
    p1 = __builtin_amdgcn_mfma_f32_32x32x16_bf16(b1, qr[d0], p1, 0, 0, 0); }
}
__device__ __forceinline__ void wmask(f32x16& p0, f32x16& p1, const float* tab, int kb, int qpos, int hi) {
  const float* tp = tab + (kb - qpos + 384 + 4 * hi);
#pragma unroll
  for (int r = 0; r < 16; ++r) { const int c = (r & 3) + 8 * (r >> 2); p0[r] += tp[c]; p1[r] += tp[32 + c];
    if ((r & 3) == 3) { asm volatile("" ::: "memory"); __builtin_amdgcn_sched_barrier(0); } }
}
__device__ __forceinline__ int v_st(int k, int c) { const int kk = (k & ~0xC) | ((k & 4) << 1) | ((k & 8) >> 1); return ((kk >> 3) * 4 + (c >> 5)) * 512 + ((kk & 7) * 32 + (c & 31)) * 2; }
__device__ __forceinline__ int v_rd_base(int lane) { return ((lane & 3) << 3) | (((lane >> 2) & 3) << 6) | (((lane >> 4) & 1) << 5) | (((lane >> 5) & 1) << 8); }
constexpr int v_rd_off(int d0, int ks, int half) { return d0 * 512 + ks * 4096 + half * 2048; }
template <int OFF> __device__ __forceinline__ s16x4 tr_read(int vb) {
  s16x4 r; asm volatile("ds_read_b64_tr_b16 %0, %1 offset:%2" : "=&v"(r) : "v"(vb), "i"(OFF) : "memory"); return r;
}
template <int D0> __device__ __forceinline__ void pv_one(f32x16& od, int vb, bf16x8 pa0, bf16x8 pa1, bf16x8 pa2, bf16x8 pa3) {
  const s16x4 l0 = tr_read<v_rd_off(D0, 0, 0)>(vb), h0 = tr_read<v_rd_off(D0, 0, 1)>(vb), l1 = tr_read<v_rd_off(D0, 1, 0)>(vb), h1 = tr_read<v_rd_off(D0, 1, 1)>(vb);
  const s16x4 l2 = tr_read<v_rd_off(D0, 2, 0)>(vb), h2 = tr_read<v_rd_off(D0, 2, 1)>(vb), l3 = tr_read<v_rd_off(D0, 3, 0)>(vb), h3 = tr_read<v_rd_off(D0, 3, 1)>(vb);
  asm volatile("s_waitcnt lgkmcnt(0)" ::: "memory"); SBAR();
#define PK(L, H) (bf16x8){L[0], L[1], L[2], L[3], H[0], H[1], H[2], H[3]}
  od = __builtin_amdgcn_mfma_f32_32x32x16_bf16(pa0, PK(l0, h0), od, 0, 0, 0);
  od = __builtin_amdgcn_mfma_f32_32x32x16_bf16(pa1, PK(l1, h1), od, 0, 0, 0);
  od = __builtin_amdgcn_mfma_f32_32x32x16_bf16(pa2, PK(l2, h2), od, 0, 0, 0);
  od = __builtin_amdgcn_mfma_f32_32x32x16_bf16(pa3, PK(l3, h3), od, 0, 0, 0);
#undef PK
}
__device__ __forceinline__ void pv_d0(f32x16* o, int vb, bf16x8 pa0, bf16x8 pa1, bf16x8 pa2, bf16x8 pa3) {
  pv_one<0>(o[0], vb, pa0, pa1, pa2, pa3); pv_one<1>(o[1], vb, pa0, pa1, pa2, pa3); pv_one<2>(o[2], vb, pa0, pa1, pa2, pa3); pv_one<3>(o[3], vb, pa0, pa1, pa2, pa3);
}

template <bool WINDOW, int ldq, int ldk, int ldo, int SDEPTH>
__device__ __forceinline__ void attn_unit(const bf16_t* __restrict__ Qb, const bf16_t* __restrict__ Kh, const bf16_t* __restrict__ Vh,
                                          bf16_t* __restrict__ Ob, int NT, int qpos0, int kpos0, float sink, char* lds) {
  int tid = threadIdx.x; asm volatile("" : "+v"(tid));
  const int wid = tid >> 6, lane = tid & 63, r32 = lane & 31, hi = lane >> 5;
  bf16_t* V_lds = (bf16_t*)lds; bf16_t* K_lds = (bf16_t*)(lds + 2 * SHM_V);
  float* ws = (float*)(lds + 2 * SHM_V + 2 * SHM_K) + wid * 64; float* li_l = ws; float* al_l = ws + 32;
  const float* tab = (const float*)(lds + TAB_OFF);
  float m_reg = WINDOW ? sink * (1.0f / SCALE) : -1e30f, l_reg = WINDOW ? 1.0f : 0.0f; f32x16 o[4] = {}; bf16x8 qr[8];
  const int qpos = qpos0 + wid * QBLK + r32;
  const bf16_t* Qw = Qb + (long)(wid * QBLK + r32) * ldq + hi * 8;
#pragma unroll
  for (int d0 = 0; d0 < 8; ++d0) qr[d0] = ld8(Qw + d0 * 16);
  const int sr = tid >> 4, sc = (tid & 15) * 8, vst0 = v_st(sr, sc), vst1 = v_st(32 + sr, sc);
  const int vb0 = (int)(uintptr_t)V_lds + v_rd_base(lane);
  struct { bf16x8 vs0, vs1, ks0, ks1; } sr_[SDEPTH];
#define SLOAD(i, k0) do { sr_[i].vs0 = ld8(&Vh[(long)((k0) + sr) * ldk + sc]); sr_[i].vs1 = ld8(&Vh[(long)((k0) + 32 + sr) * ldk + sc]); \
    sr_[i].ks0 = ld8(&Kh[(long)((k0) + sr) * ldk + sc]); sr_[i].ks1 = ld8(&Kh[(long)((k0) + 32 + sr) * ldk + sc]); } while (0)
#define SWRITE(b, i) do { *(bf16x8*)((char*)V_lds + (b) * SHM_V + vst0) = sr_[i].vs0;          \
    *(bf16x8*)((char*)V_lds + (b) * SHM_V + vst1) = sr_[i].vs1; int kc = sc * 2;               \
    *(bf16x8*)((char*)K_lds + (b) * SHM_K + KSWZ(sr, kc)) = sr_[i].ks0;                       \
    *(bf16x8*)((char*)K_lds + (b) * SHM_K + KSWZ(32 + sr, kc)) = sr_[i].ks1; } while (0)
#define SWAIT() do { if constexpr (SDEPTH == 2) asm volatile("s_waitcnt vmcnt(4)" ::: "memory"); else asm volatile("s_waitcnt vmcnt(0)" ::: "memory"); } while (0)
#define RESC(a) do { if (__any((a) < 1.f)) { if (hi == 0) al_l[r32] = (a); asm volatile("s_waitcnt lgkmcnt(0)" ::: "memory"); \
    _Pragma("unroll") for (int d = 0; d < 4; ++d) _Pragma("unroll") for (int r = 0; r < 16; ++r) o[d][r] *= al_l[crow(r, hi)]; } } while (0)
  f32x16 pA0, pA1, pB0, pB1; float mnA, mnB, alA, alB; bf16x8 pa0, pa1, pa2, pa3;
  constexpr int SE = 0, SO = SDEPTH - 1;
  SLOAD(SE, 0); asm volatile("s_waitcnt vmcnt(0)" ::: "memory"); SWRITE(0, SE); __syncthreads();
  qkt(pA0, pA1, K_lds, qr, r32, hi); if (WINDOW) wmask(pA0, pA1, tab, kpos0, qpos, hi); partialSM(pA0, pA1, m_reg, mnA, alA);
  SLOAD(SO, KVBLK); if constexpr (SDEPTH == 2) { if (2 < NT) SLOAD(SE, 2 * KVBLK); }
  SWAIT(); SWRITE(1, SO); __syncthreads();
  for (int j = 1; j + 1 < NT; j += 2) {
    SBAR(); qkt(pB0, pB1, (bf16_t*)((char*)K_lds + SHM_K), qr, r32, hi); if (WINDOW) wmask(pB0, pB1, tab, kpos0 + j * KVBLK, qpos, hi);
    finishSM(pA0, pA1, alA, l_reg, pa0, pa1, pa2, pa3); SBAR();
    SLOAD(SO, (j + SDEPTH) * KVBLK); SBAR();
    pv_d0(o, vb0, pa0, pa1, pa2, pa3); partialSM(pB0, pB1, m_reg, mnB, alB);
    __syncthreads(); SWAIT(); SWRITE(0, SE);
    RESC(alB); __syncthreads();
    SBAR(); qkt(pA0, pA1, K_lds, qr, r32, hi); if (WINDOW) wmask(pA0, pA1, tab, kpos0 + (j + 1) * KVBLK, qpos, hi);
    finishSM(pB0, pB1, alB, l_reg, pa0, pa1, pa2, pa3); SBAR();
    if (SDEPTH == 1 || j + 3 < NT) SLOAD(SE, (j + 1 + SDEPTH) * KVBLK); SBAR();
    pv_d0(o, vb0 + (int)SHM_V, pa0, pa1, pa2, pa3); partialSM(pA0, pA1, m_reg, mnA, alA);
    __syncthreads(); SWAIT(); SWRITE(1, SO);
    RESC(alA); __syncthreads();
  }
  SBAR(); qkt(pB0, pB1, (bf16_t*)((char*)K_lds + SHM_K), qr, r32, hi); if (WINDOW) wmask(pB0, pB1, tab, kpos0 + (NT - 1) * KVBLK, qpos, hi);
  finishSM(pA0, pA1, alA, l_reg, pa0, pa1, pa2, pa3); SBAR();
  pv_d0(o, vb0, pa0, pa1, pa2, pa3); partialSM(pB0, pB1, m_reg, mnB, alB);
  __syncthreads(); RESC(alB);
  finishSM(pB0, pB1, alB, l_reg, pa0, pa1, pa2, pa3); SBAR();
  pv_d0(o, vb0 + (int)SHM_V, pa0, pa1, pa2, pa3);
  if (hi == 0) li_l[r32] = l_reg; asm volatile("s_waitcnt lgkmcnt(0)" ::: "memory");
  float rli[16];
#pragma unroll
  for (int r = 0; r < 16; ++r) rli[r] = __builtin_amdgcn_rcpf(li_l[crow(r, hi)]);
  bf16_t* Ow = Ob + (long)(wid * QBLK) * ldo;
#pragma unroll
  for (int r = 0; r < 16; ++r) { const int orow = crow(r, hi);
#pragma unroll
    for (int d0 = 0; d0 < 4; ++d0) { const float v = o[d0][r] * rli[r]; Ow[(long)orow * ldo + d0 * 32 + r32] = (bf16_t)(cvtpk(v, v) & 0xffffu); } }
#undef SLOAD
#undef SWRITE
#undef SWAIT
#undef RESC
}
#undef KSWZ
#undef SBAR
}

constexpr int NWAVES = 8, NTHREADS = 512;
constexpr int DM = 2048, SEQ = 4096, NSEQ = 6, MTOK = NSEQ * SEQ  , MEMLEN = 256, MMEM = NSEQ * MEMLEN  , NPROMPT = 4 * SEQ;
constexpr int DEPTH = 4, NNORM = 7;
constexpr int GH = 4096, NGRP = 8;
constexpr int QKVW = 3072, NHEAD = 16;
constexpr int DRNN = 2816, RBD = 176;
constexpr int MEMW = 512, DFF = 5632;
constexpr float EPS = 1e-6f;
enum { I_XP = 0, I_XS, I_MP, I_MS, I_NORMS, I_REL, I_AWIN, I_ALNG, I_ALNB, I_AWS, I_ABS, I_AWOUT, I_BQKV, I_BSINK, I_BWO, I_CWIN, I_CCONVW, I_CCONVB, I_CWA, I_CBA, I_CWX, I_CBX, I_CLAM, I_CWOUT,
       I_MWQ, I_MWKV, I_MWO, I_FGU, I_FDN, N_IN };
constexpr size_t MiB = 1u << 20;
constexpr size_t WS_CTL = 0, CTL_ZERO_BYTES = 1 * MiB;
constexpr size_t WS_W = 1 * MiB;
constexpr size_t W_MQKV = WS_W, W_MO = WS_W + 6 * MiB, W_GU = WS_W + 8 * MiB, W_DN = WS_W + 52 * MiB, W_MIX = WS_W + 74 * MiB;
constexpr size_t W_MIX2 = W_MIX + 32 * MiB;
constexpr size_t W_GATES = W_MIX + 43 * MiB, W_SPL = W_MIX + 49 * MiB;
constexpr size_t WS_XN = 125 * MiB;
constexpr size_t WS_HB = 227 * MiB;
constexpr size_t WS_BIG = 323 * MiB;
constexpr size_t WS_END = WS_BIG + 680 * MiB;
constexpr size_t B_HF = WS_BIG;
constexpr size_t B_U = WS_BIG, B_VT = WS_BIG + 192 * MiB, B_PST = WS_BIG + 384 * MiB;
constexpr size_t B_QKV = WS_BIG, B_OB = WS_BIG + 144 * MiB;
constexpr size_t B_LA = WS_BIG, B_UU = WS_BIG + 264 * MiB, B_GATE = WS_BIG + 528 * MiB, B_RNN = WS_BIG, B_CAR = WS_BIG + 660 * MiB;
constexpr size_t B_XC = WS_XN;
constexpr size_t B_QM = WS_BIG, B_KVM = WS_BIG + 24 * MiB, B_OM = WS_BIG + 28 * MiB;
static_assert(W_GATES + 6 * MiB <= W_SPL && W_SPL + 64 * 1024 <= WS_XN && W_MIX2 + 16 * MiB <= WS_XN, "weight map");
static_assert((size_t)MTOK * 4096 * 2 <= WS_BIG - WS_XN, "XC fits XN|HB");
constexpr int CW_TMO = 0, CW_BAR = 4096;

constexpr int RING_BYTES = 131072, LDSCTL_OFF = RING_BYTES, MISC_OFF = LDSCTL_OFF + 320, LDS_BYTES = 147456;

#define GAS __attribute__((address_space(1)))
#define LAS __attribute__((address_space(3)))
typedef unsigned short bf16;
typedef unsigned v4u __attribute__((ext_vector_type(4)));
typedef unsigned v2u __attribute__((ext_vector_type(2)));
typedef float f32x4 __attribute__((ext_vector_type(4)));
typedef float f32x2 __attribute__((ext_vector_type(2)));
typedef short bf16x8 __attribute__((ext_vector_type(8)));
typedef _Float16 h2 __attribute__((ext_vector_type(2)));
#define LDS_WAIT() asm volatile("s_waitcnt lgkmcnt(0)" ::: "memory")
#define VM_WAIT() asm volatile("s_waitcnt vmcnt(0)" ::: "memory")
__device__ __forceinline__ unsigned f2bf(float f) { unsigned u = __builtin_bit_cast(unsigned, f); return (u + 0x7fffu + ((u >> 16) & 1u)) >> 16; }
__device__ __forceinline__ unsigned pk2(float lo, float hi) { return f2bf(lo) | (f2bf(hi) << 16); }
__device__ __forceinline__ float bflo(unsigned w) { return __uint_as_float(w << 16); }
__device__ __forceinline__ float bfhi(unsigned w) { return __uint_as_float(w & 0xffff0000u); }
__device__ __forceinline__ float ex(float x) { return __builtin_amdgcn_exp2f(1.4426950408889634f * x); }


#define XB_TMO      128
#define XB_XCNT(j)  (256  + 64 * (j))
#define XB_XSUB(j)  (1280 + 64 * (j))
#define XB_XGEN(j)  (2304 + 64 * (j))
#define XB_TOP      3328
#define XB_TOPGEN   3392
#define XCD_BAR_WORDS 3456
#define XB_SPIN_CAP (1u << 18)

__device__ __forceinline__ unsigned xb_ld(unsigned* p)              { return __hip_atomic_load(p, __ATOMIC_RELAXED, __HIP_MEMORY_SCOPE_AGENT); }
__device__ __forceinline__ unsigned xb_add(unsigned* p, unsigned v) { return __hip_atomic_fetch_add(p, v, __ATOMIC_RELAXED, __HIP_MEMORY_SCOPE_AGENT); }
__device__ __forceinline__ unsigned xb_xcc_id() { return (unsigned)__builtin_amdgcn_s_getreg((3 << 11) | 20) & 0xFu; }
#define XB_SPIN(cond, bar) do { unsigned _sp = 0; while (cond) { __builtin_amdgcn_s_sleep(1); \
    if ((++_sp & 255u) == 0u) { if (xb_ld(&(bar)[XB_TMO])) break; if (_sp > XB_SPIN_CAP) { atomicAdd(&(bar)[XB_TMO], 1u); break; } } } } while (0)

struct XcdBarrier {
    unsigned* bar; unsigned x;
    volatile LAS unsigned* st;
};

__device__ __forceinline__ XcdBarrier xcd_barrier_post(unsigned* bar, volatile LAS unsigned* st) {
    XcdBarrier b; b.bar = bar; b.x = xb_xcc_id(); b.st = st;
    if (threadIdx.x == 0) (void)xb_add(&bar[XB_XCNT(b.x)], 1u);
    return b;
}
__device__ __forceinline__ void xcd_barrier_complete(unsigned* bar, unsigned x, unsigned& nloc, unsigned& nx) {
    const unsigned G = gridDim.x * gridDim.y * gridDim.z;
    unsigned sum, cnt, mine, sp = 0u;
    for (;;) {
        sum = 0u; cnt = 0u; mine = 0u;
#pragma unroll
        for (unsigned j = 0; j < 16; ++j) { const unsigned c = xb_ld(&bar[XB_XCNT(j)]); sum += c; cnt += (c > 0u) ? 1u : 0u; mine = (j == x) ? c : mine; }
        if (sum == G) break;
        __builtin_amdgcn_s_sleep(1);
        if ((++sp & 255u) == 0u) { if (xb_ld(&bar[XB_TMO])) break; if (sp > XB_SPIN_CAP) { atomicAdd(&bar[XB_TMO], 1u); break; } }
    }
    nloc = mine > 0u ? mine : 1u; nx = cnt > 0u ? cnt : 1u;
}

__device__ __forceinline__ void xcd_barrier(const XcdBarrier& b) {
    asm volatile("s_waitcnt vmcnt(0)" ::: "memory");
    __syncthreads();
    if (threadIdx.x == 0) {
        unsigned* bar = b.bar;
        __builtin_amdgcn_s_waitcnt(0);
        unsigned nloc = b.st[0], nx = b.st[1];
        if (nloc == 0u) { xcd_barrier_complete(bar, b.x, nloc, nx); b.st[0] = nloc; b.st[1] = nx; }
        const unsigned old = xb_add(&bar[XB_XSUB(b.x)], 1u);
        const unsigned gen = old / nloc;
        if (old + 1u == (gen + 1u) * nloc) {
            __builtin_amdgcn_fence(__ATOMIC_RELEASE, "agent");
            asm volatile("s_waitcnt vmcnt(0)" ::: "memory");
            const unsigned og = xb_add(&bar[XB_TOP], 1u);
            const unsigned tg = og / nx;
            if (og + 1u == (tg + 1u) * nx) xb_add(&bar[XB_TOPGEN], 1u);
            else XB_SPIN(xb_ld(&bar[XB_TOPGEN]) == tg, bar);
            __builtin_amdgcn_fence(__ATOMIC_ACQUIRE, "agent");
            xb_add(&bar[XB_XGEN(b.x)], 1u);
            asm volatile("s_waitcnt vmcnt(0)" ::: "memory");
        } else {
            XB_SPIN(xb_ld(&bar[XB_XGEN(b.x)]) == gen, bar);
            __builtin_amdgcn_fence(__ATOMIC_ACQUIRE, "agent");
            asm volatile("s_waitcnt vmcnt(0)" ::: "memory");
        }
    }
    __syncthreads();
}
__device__ __forceinline__ float wave_sum(float v) {
#pragma unroll
    for (int o = 1; o < 64; o <<= 1) v += __shfl_xor(v, o);
    return v;
}
__device__ __forceinline__ void conv_job(const float* __restrict__ W, int K, int N, bf16* __restrict__ WT, int maptype, LAS float* scr, int gw, int NGW, int lane) {
    const int nblk = N / 32, nitems = (K / 64) * nblk;
    for (int it = gw; it < nitems; it += NGW) {
        const int kb = it / nblk, nb = it - kb * nblk, k0 = 64 * kb, n0 = 32 * nb;
        int drow0 = n0;
        if (maptype == 1) { const int half = N >> 1; const int nn = n0 < half ? n0 : n0 - half; drow0 = (nn >> 7) * 256 + (nn & 127) + (n0 < half ? 0 : 128); }
#pragma unroll 8
        for (int i = 0; i < 32; ++i) { const int kk = 2 * i + (lane >> 5); scr[kk * 33 + (lane & 31)] = W[(size_t)(k0 + kk) * N + n0 + (lane & 31)]; }
        LDS_WAIT(); asm volatile("" ::: "memory");
        const int c = lane & 7;
#pragma unroll
        for (int j = 0; j < 4; ++j) { const int n = (lane >> 3) + 8 * j; const LAS float* s = scr + (8 * c) * 33 + n;
            v4u o; o.x = pk2(s[0 * 33], s[1 * 33]); o.y = pk2(s[2 * 33], s[3 * 33]); o.z = pk2(s[4 * 33], s[5 * 33]); o.w = pk2(s[6 * 33], s[7 * 33]);
            *(v4u*)(WT + (size_t)(drow0 + n) * K + k0 + 8 * c) = o; }
        LDS_WAIT(); asm volatile("" ::: "memory");
    }
}
__device__ __forceinline__ void gates_job(const float* __restrict__ wa, const float* __restrict__ wx, bf16* __restrict__ GW, int gt, int NGT) {
    for (int it = gt; it < 16 * 768 * 32; it += NGT) {
        const int k8 = it & 31, row = (it >> 5) % 768, h = it / (768 * 32);
        const int j = row >> 8, bj = (row >> 7) & 1, cs = row & 127, s = j * 128 + cs;
        float v[8];
#pragma unroll
        for (int e = 0; e < 8; ++e) v[e] = 0.f;
        if (s < 352) { const int d = s >= 176 ? 1 : 0, cb = s - 176 * d; const float* src = (bj ? wx : wa) + ((size_t)(d * 16 + h) * 176) * 176 + cb;
#pragma unroll
            for (int e = 0; e < 8; ++e) { const int k = 8 * k8 + e; if (k < 176) v[e] = src[(size_t)k * 176]; } }
        v4u o; o.x = pk2(v[0], v[1]); o.y = pk2(v[2], v[3]); o.z = pk2(v[4], v[5]); o.w = pk2(v[6], v[7]);
        *(v4u*)(GW + ((size_t)(h * 768 + row) * 256 + 8 * k8)) = o;
    }
}

template <int MODE>
__device__ __forceinline__ void norm_pass(const float* __restrict__ xp, const float* __restrict__ xs, GAS float* __restrict__ X, const bf16* __restrict__ Hb,
                                          const float* __restrict__ g_post, const float* __restrict__ g_pre, bf16* __restrict__ XN, int gw, int NGW, int lane) {
    for (int row = gw; row < MTOK; row += NGW) {
        const GAS float* xin = MODE == 0 ? (const GAS float*)(row < NPROMPT ? xp + (size_t)row * DM : xs + (size_t)(row - NPROMPT) * DM) : (const GAS float*)(X + (size_t)row * DM);
        f32x4 x[8];
#pragma unroll
        for (int j = 0; j < 8; ++j) x[j] = ((const GAS f32x4*)xin)[lane + 64 * j];
        if (MODE != 0) {
            v2u hw[8];
#pragma unroll
            for (int j = 0; j < 8; ++j) hw[j] = ((const v2u*)(Hb + (size_t)row * DM))[lane + 64 * j];
            float ss = 0.f;
#pragma unroll
            for (int j = 0; j < 8; ++j) { const float a = bflo(hw[j].x), b = bfhi(hw[j].x), c = bflo(hw[j].y), d = bfhi(hw[j].y); ss += (a * a + b * b) + (c * c + d * d); }
            const float rstd = rsqrtf(wave_sum(ss) * (1.0f / DM) + EPS);
#pragma unroll
            for (int j = 0; j < 8; ++j) { const f32x4 g = ((const f32x4*)g_post)[lane + 64 * j];
                x[j].x += bflo(hw[j].x) * rstd * g.x; x[j].y += bfhi(hw[j].x) * rstd * g.y; x[j].z += bflo(hw[j].y) * rstd * g.z; x[j].w += bfhi(hw[j].y) * rstd * g.w; }
        }
#pragma unroll
        for (int j = 0; j < 8; ++j) ((GAS f32x4*)(X + (size_t)row * DM))[lane + 64 * j] = x[j];
        if (MODE != 2) {
            float s2 = 0.f;
#pragma unroll
            for (int j = 0; j < 8; ++j) s2 += (x[j].x * x[j].x + x[j].y * x[j].y) + (x[j].z * x[j].z + x[j].w * x[j].w);
            const float r2 = rsqrtf(wave_sum(s2) * (1.0f / DM) + EPS);
#pragma unroll
            for (int j = 0; j < 8; ++j) { const f32x4 g = ((const f32x4*)g_pre)[lane + 64 * j];
                v2u o; o.x = pk2(x[j].x * r2 * g.x, x[j].y * r2 * g.y); o.y = pk2(x[j].z * r2 * g.z, x[j].w * r2 * g.w);
                ((v2u*)(XN + (size_t)row * DM))[lane + 64 * j] = o; }
        }
    }
}
__device__ __forceinline__ void mem_norm(const float* __restrict__ mp, const float* __restrict__ ms, const float* __restrict__ g, bf16* __restrict__ XN, int gw, int NGW, int lane) {
    for (int r = gw; r < MMEM; r += NGW) {
        const float* xin = r < 4 * MEMLEN ? mp + (size_t)r * DM : ms + (size_t)(r - 4 * MEMLEN) * DM;
        f32x4 x[8]; float s2 = 0.f;
#pragma unroll
        for (int j = 0; j < 8; ++j) { x[j] = ((const f32x4*)xin)[lane + 64 * j]; s2 += (x[j].x * x[j].x + x[j].y * x[j].y) + (x[j].z * x[j].z + x[j].w * x[j].w); }
        const float r2 = rsqrtf(wave_sum(s2) * (1.0f / DM) + EPS);
#pragma unroll
        for (int j = 0; j < 8; ++j) { const f32x4 gg = ((const f32x4*)g)[lane + 64 * j];
            v2u o; o.x = pk2(x[j].x * r2 * gg.x, x[j].y * r2 * gg.y); o.y = pk2(x[j].z * r2 * gg.z, x[j].w * r2 * gg.w);
            ((v2u*)(XN + (size_t)(MTOK + r) * DM))[lane + 64 * j] = o; }
    }
}

__device__ __forceinline__ void sgu_unit(int n, int g, const bf16* __restrict__ VT, const f32x2* __restrict__ PST, bf16* __restrict__ U, const float* __restrict__ Ws  ,
                                         const float* __restrict__ bs  , const float* __restrict__ lng, const float* __restrict__ lnb, LAS unsigned char* lds, int tid, int lane, int wave) {
    constexpr int WROW = 272;
    LAS unsigned char* WSP = lds; LAS float* MU = (LAS float*)(lds + 128 * WROW); LAS float* RS = MU + 128; LAS float* K1 = RS + 128; LAS float* K2 = K1 + 128; LAS float* BSL = K2 + 128;
    __syncthreads();
    {
        const int tk = tid >> 2, part = tid & 3; float s = 0.f, q = 0.f;
        const f32x2* p = PST + (size_t)(128 * n + tk) * 32 + part * 8;
#pragma unroll
        for (int i = 0; i < 8; ++i) { const f32x2 v = p[i]; s += v.x; q += v.y; }
        s += __shfl_xor(s, 1); q += __shfl_xor(q, 1); s += __shfl_xor(s, 2); q += __shfl_xor(q, 2);
        if (part == 0) { const float mean = s * (1.0f / GH); const float var = fmaxf(q * (1.0f / GH) - mean * mean, 0.f); MU[tk] = mean; RS[tk] = rsqrtf(var + EPS); }
    }
    __syncthreads();
    {
        const int p = tid >> 2, part = tid & 3; float k1 = 0.f, k2 = 0.f;
        const f32x4* wrow = (const f32x4*)(Ws + p * 128 + part * 32);
#pragma unroll
        for (int i = 0; i < 8; ++i) { const f32x4 w = wrow[i]; const int q0 = part * 32 + 4 * i;
            const float r0 = RS[q0], r1 = RS[q0 + 1], r2 = RS[q0 + 2], r3 = RS[q0 + 3];
            const float a = w.x * r0, b = w.y * r1, c = w.z * r2, d = w.w * r3;
            k1 += (a * MU[q0] + b * MU[q0 + 1]) + (c * MU[q0 + 2] + d * MU[q0 + 3]); k2 += (w.x + w.y) + (w.z + w.w);
            v2u o; o.x = pk2(a, b); o.y = pk2(c, d); *(LAS v2u*)(WSP + p * WROW + q0 * 2) = o; }
        k1 += __shfl_xor(k1, 1); k2 += __shfl_xor(k2, 1); k1 += __shfl_xor(k1, 2); k2 += __shfl_xor(k2, 2);
        if (part == 0) { K1[p] = k1; K2[p] = k2; BSL[p] = bs[p]; }
    }
    __syncthreads();
    const int fr = lane & 15, fq = lane >> 4, cbase = 512 * g + 64 * wave;
    bf16x8 a[4][4];
#pragma unroll
    for (int ci = 0; ci < 4; ++ci)
#pragma unroll
        for (int ks = 0; ks < 4; ++ks) a[ci][ks] = *(const bf16x8*)(VT + (size_t)(cbase + 16 * ci + fr) * MTOK + 128 * n + 32 * ks + 8 * fq);
    f32x4 lg[4], lb[4];
#pragma unroll
    for (int ci = 0; ci < 4; ++ci) { lg[ci] = *(const f32x4*)(lng + cbase + 16 * ci + 4 * fq); lb[ci] = *(const f32x4*)(lnb + cbase + 16 * ci + 4 * fq); }
#pragma unroll 1
    for (int pi = 0; pi < 8; ++pi) {
        bf16x8 b[4];
#pragma unroll
        for (int ks = 0; ks < 4; ++ks) b[ks] = *(const LAS bf16x8*)(WSP + (16 * pi + fr) * WROW + (32 * ks + 8 * fq) * 2);
        const int p = 16 * pi + fr; const float k1p = K1[p], k2p = K2[p], bsp = BSL[p];
        f32x4 acc[4];
#pragma unroll
        for (int ci = 0; ci < 4; ++ci) acc[ci] = (f32x4){0.f, 0.f, 0.f, 0.f};
#pragma unroll
        for (int ks = 0; ks < 4; ++ks)
#pragma unroll
            for (int ci = 0; ci < 4; ++ci) acc[ci] = __builtin_amdgcn_mfma_f32_16x16x32_bf16(a[ci][ks], b[ks], acc[ci], 0, 0, 0);
        bf16* urow = U + (size_t)(128 * n + p) * GH + cbase + 4 * fq;
#pragma unroll
        for (int ci = 0; ci < 4; ++ci) { const v2u uw = *(const v2u*)(urow + 16 * ci);
            const float v0 = lg[ci].x * (acc[ci].x - k1p) + lb[ci].x * k2p + bsp, v1 = lg[ci].y * (acc[ci].y - k1p) + lb[ci].y * k2p + bsp;
            const float v2 = lg[ci].z * (acc[ci].z - k1p) + lb[ci].z * k2p + bsp, v3 = lg[ci].w * (acc[ci].w - k1p) + lb[ci].w * k2p + bsp;
            v2u o; o.x = pk2(bflo(uw.x) * v0, bfhi(uw.x) * v1); o.y = pk2(bflo(uw.y) * v2, bfhi(uw.y) * v3);
            *(v2u*)(urow + 16 * ci) = o; }
    }
}

__device__ __forceinline__ void conv_phase(const bf16* __restrict__ RNN, const float* __restrict__ cw  , const float* __restrict__ cb, bf16* __restrict__ XC, int gt, int NGT) {
    for (long it = gt; it < (long)MTOK * 512; it += NGT) {
        const int s = (int)(it & 511), t = (int)(it >> 9), h = s >> 5, j = s & 31;
        v4u o = (v4u){0u, 0u, 0u, 0u};
        if (j < 22) {
            const int ch = h * 176 + 8 * j, tl = t & (SEQ - 1);
            float acc[8];
            { const f32x4 b0 = *(const f32x4*)(cb + ch), b1 = *(const f32x4*)(cb + ch + 4); acc[0] = b0.x; acc[1] = b0.y; acc[2] = b0.z; acc[3] = b0.w; acc[4] = b1.x; acc[5] = b1.y; acc[6] = b1.z; acc[7] = b1.w; }
#pragma unroll
            for (int k = 0; k < 4; ++k) { const int tt = tl + k - 2;
                if (tt >= 0 && tt < SEQ) { const v4u xw = *(const v4u*)(RNN + (size_t)(t + k - 2) * DRNN + ch);
                    const f32x4 w0 = *(const f32x4*)(cw + k * DRNN + ch), w1 = *(const f32x4*)(cw + k * DRNN + ch + 4);
                    acc[0] += bflo(xw.x) * w0.x; acc[1] += bfhi(xw.x) * w0.y; acc[2] += bflo(xw.y) * w0.z; acc[3] += bfhi(xw.y) * w0.w;
                    acc[4] += bflo(xw.z) * w1.x; acc[5] += bfhi(xw.z) * w1.y; acc[6] += bflo(xw.w) * w1.z; acc[7] += bfhi(xw.w) * w1.w; } }
            o.x = pk2(acc[0], acc[1]); o.y = pk2(acc[2], acc[3]); o.z = pk2(acc[4], acc[5]); o.w = pk2(acc[6], acc[7]);
        }
        *(v4u*)(XC + (size_t)t * 4096 + s * 8) = o;
    }
}
__device__ __forceinline__ void scan1_phase(_Float16* __restrict__ LA, _Float16* __restrict__ UU, float* __restrict__ CT, float* __restrict__ HE, int gw, int NGW, int lane) {
    for (int it = gw; it < NSEQ * 2 * 64 * 22; it += NGW) {
        const int cg = it % 22, ck = (it / 22) & 63, d = (it / (22 * 64)) & 1, b = it / (22 * 64 * 2);
        const int ch = 128 * cg + 2 * lane, t0 = b * SEQ + ck * 64;
        const size_t dbase = (size_t)d * MTOK * DRNN;
        float c0 = 0.f, c1 = 0.f, h0 = 0.f, h1 = 0.f;
#pragma unroll 1
        for (int sb = 0; sb < 64; sb += 16) {
            h2 la[16], uu[16];
#pragma unroll
            for (int s = 0; s < 16; ++s) { const int t = d == 0 ? t0 + sb + s : t0 + 63 - (sb + s); const size_t o = dbase + (size_t)t * DRNN + ch;
                la[s] = *(const h2*)(LA + o); uu[s] = *(const h2*)(UU + o); }
#pragma unroll
            for (int s = 0; s < 16; ++s) { const int t = d == 0 ? t0 + sb + s : t0 + 63 - (sb + s); const size_t o = dbase + (size_t)t * DRNN + ch;
                const float l0 = (float)la[s].x, l1 = (float)la[s].y;
                c0 += l0; c1 += l1; h0 = ex(l0) * h0 + (float)uu[s].x; h1 = ex(l1) * h1 + (float)uu[s].y;
                h2 co, ho; co.x = (_Float16)c0; co.y = (_Float16)c1; ho.x = (_Float16)h0; ho.y = (_Float16)h1;
                *(h2*)(LA + o) = co; *(h2*)(UU + o) = ho; }
        }
        const int cs = d == 0 ? ck : 63 - ck;
        const size_t co = ((size_t)((b * 2 + d) * 64 + cs)) * DRNN + ch;
        *(f32x2*)(CT + co) = (f32x2){c0, c1}; *(f32x2*)(HE + co) = (f32x2){h0, h1};
    }
}
__device__ __forceinline__ void scan2_phase(const _Float16* __restrict__ LA, const _Float16* __restrict__ UU, const float* __restrict__ CT, const float* __restrict__ HE, bf16* __restrict__ GATE, int gw, int NGW, int lane) {
    for (int it = gw; it < NSEQ * 64 * 22; it += NGW) {
        const int cg = it % 22, ck = (it / 22) & 63, b = it / (22 * 64);
        const int ch = 128 * cg + 2 * lane, t0 = b * SEQ + ck * 64;
        float hin[2][2];
#pragma unroll
        for (int d = 0; d < 2; ++d) { const int cs = d == 0 ? ck : 63 - ck; float a0 = 0.f, a1 = 0.f;
            const size_t cb = ((size_t)((b * 2 + d) * 64)) * DRNN + ch;
            for (int c = 0; c < cs; ++c) { const f32x2 ct = *(const f32x2*)(CT + cb + (size_t)c * DRNN), he = *(const f32x2*)(HE + cb + (size_t)c * DRNN);
                a0 = ex(ct.x) * a0 + he.x; a1 = ex(ct.y) * a1 + he.y; }
            hin[d][0] = a0; hin[d][1] = a1; }
        const size_t d1 = (size_t)MTOK * DRNN;
#pragma unroll 4
        for (int s = 0; s < 64; ++s) { const size_t o = (size_t)(t0 + s) * DRNN + ch;
            const h2 lf = *(const h2*)(LA + o), uf = *(const h2*)(UU + o), lb = *(const h2*)(LA + d1 + o), ub = *(const h2*)(UU + d1 + o);
            const unsigned gwd = *(const unsigned*)(GATE + o);
            const float y0 = ((float)uf.x + ex((float)lf.x) * hin[0][0]) + ((float)ub.x + ex((float)lb.x) * hin[1][0]);
            const float y1 = ((float)uf.y + ex((float)lf.y) * hin[0][1]) + ((float)ub.y + ex((float)lb.y) * hin[1][1]);
            *(unsigned*)(GATE + o) = pk2(bflo(gwd) * y0, bfhi(gwd) * y1); }
    }
}

#ifndef MK_SITES
#define MK_SITES 0xFFFF
#endif
struct Args { const float* in[N_IN]; float* out; unsigned char* ws; int ph_lo, ph_hi; };
static_assert(sizeof(Args) == (N_IN + 2) * 8 + 8, "Args has no padding");

__device__ __forceinline__ bool slot_active(int kind, int slot) { return slot <= 2 || (slot >= 3 && slot <= 5 && kind == 2) || (slot >= 6 && slot <= 14); }

__global__ void __launch_bounds__(NTHREADS, 2) fwd(Args args) {
    extern __shared__ __attribute__((aligned(16))) unsigned char lds_raw[];
    LAS unsigned char* lds = (LAS unsigned char*)lds_raw;
    for (int u = threadIdx.x; u < (LDS_BYTES - LDSCTL_OFF) / 4; u += NTHREADS) ((LAS unsigned*)(lds + LDSCTL_OFF))[u] = 0u;
    __syncthreads();
    const int lo = args.ph_lo, hi = args.ph_hi;
    const bool fused = (hi - lo) > 1;
    XcdBarrier bar; bar.bar = (unsigned*)(args.ws + WS_CTL) + CW_BAR; bar.x = 0; bar.st = nullptr;
    if (fused) bar = xcd_barrier_post((unsigned*)(args.ws + WS_CTL) + CW_BAR, (volatile LAS unsigned*)(lds + MISC_OFF) + 8);
#ifndef MK_KINDS
#define MK_KINDS 7
#endif
#define KIND_ON(k) (((MK_KINDS) >> (k)) & 1)
#define INS(s) ((((MK_SITES) >> (s)) & 1) && lo <= P0 + (s) && P0 + (s) < hi)
#define SEAMS(s) do { if (fused && P0 + (s) + 1 < hi) xcd_barrier(bar); } while (0)

#pragma unroll 1
    for (int L = 0; L < DEPTH; ++L) {
        unsigned char* ws_l = args.ws; asm volatile("" : "+s"(ws_l));
        GAS unsigned char* const ws = (GAS unsigned char*)ws_l;
        int tid = threadIdx.x; asm volatile("" : "+v"(tid));
        int bid = blockIdx.x, G = gridDim.x; asm volatile("" : "+s"(bid), "+s"(G));
        asm volatile("" : "+s"(bar.x));
        const int lane = tid & 63, wave = __builtin_amdgcn_readfirstlane(tid >> 6);
        const int gw = bid * NWAVES + wave, NGW = G * NWAVES, gt = bid * NTHREADS + tid, NGT = G * NTHREADS;
        bf16* const XN = (bf16*)(ws + WS_XN); bf16* const HB = (bf16*)(ws + WS_HB);
        float* X_l = args.out; asm volatile("" : "+s"(X_l));
        GAS float* const X = (GAS float*)X_l;
        const float* norms = args.in[I_NORMS];
        const int kind = L % 3, jl = L / 3, P0 = L * 16;
        const float* gN = norms + (size_t)L * NNORM * DM;
        if (INS(0)) {
            LAS float* scr = (LAS float*)(lds + wave * 8448);
            conv_job(args.in[I_MWQ] + (size_t)L * DM * MEMW, DM, MEMW, (bf16*)(ws + W_MQKV), 0, scr, gw, NGW, lane);
            conv_job(args.in[I_MWKV] + (size_t)L * DM * 2 * MEMW, DM, 2 * MEMW, (bf16*)(ws + W_MQKV) + (size_t)MEMW * DM, 0, scr, gw, NGW, lane);
            conv_job(args.in[I_MWO] + (size_t)L * MEMW * DM, MEMW, DM, (bf16*)(ws + W_MO), 0, scr, gw, NGW, lane);
            conv_job(args.in[I_FGU] + (size_t)L * DM * 2 * DFF, DM, 2 * DFF, (bf16*)(ws + W_GU), 1, scr, gw, NGW, lane);
            conv_job(args.in[I_FDN] + (size_t)L * DFF * DM, DFF, DM, (bf16*)(ws + W_DN), 0, scr, gw, NGW, lane);
            if (kind == 0) {
                conv_job(args.in[I_AWIN] + (size_t)jl * DM * 2 * GH, DM, 2 * GH, (bf16*)(ws + W_MIX), 0, scr, gw, NGW, lane);
                conv_job(args.in[I_AWOUT] + (size_t)jl * GH * DM, GH, DM, (bf16*)(ws + W_MIX2), 0, scr, gw, NGW, lane);
            } else if (kind == 1) {
                conv_job(args.in[I_BQKV], DM, QKVW, (bf16*)(ws + W_MIX), 0, scr, gw, NGW, lane);
                conv_job(args.in[I_BWO], DM, DM, (bf16*)(ws + W_MIX2), 0, scr, gw, NGW, lane);
            } else {
                conv_job(args.in[I_CWIN], DM, 2 * DRNN, (bf16*)(ws + W_MIX), 0, scr, gw, NGW, lane);
                conv_job(args.in[I_CWOUT], DRNN, DM, (bf16*)(ws + W_MIX2), 0, scr, gw, NGW, lane);
                gates_job(args.in[I_CWA], args.in[I_CWX], (bf16*)(ws + W_GATES), gt, NGT);
                for (int i = gt; i < 2 * DRNN; i += NGT) { const float xl = -args.in[I_CLAM][i]; ((float*)(ws + W_SPL))[i] = 8.0f * (fmaxf(xl, 0.f) + log1pf(expf(-fabsf(xl)))); }
            }
            if (L == 0) norm_pass<0>(args.in[I_XP], args.in[I_XS], X, nullptr, nullptr, gN, XN, gw, NGW, lane);
            SEAMS(0);
        }
        if (INS(1)) {
            {
                const int nN = kind == 0 ? 16 : (kind == 1 ? 12 : 22);
                pg8::Gemm g{XN, (const bf16*)(ws + W_MIX), DM, DM, DM};
                pg8::StaticOrder S; S.init(96, nN, G, bid, DM, DM);
                pg8::EpiGen E;
                if (kind == 0)      E = pg8::EpiGen{(bf16*)(ws + B_U), GH, 1, nullptr, 0, 0, 1 << 30, 0};
                else if (kind == 1) E = pg8::EpiGen{(bf16*)(ws + B_QKV), QKVW, 0, nullptr, 0, 0, 1 << 30, 0};
                else                E = pg8::EpiGen{(bf16*)(ws + B_GATE), DRNN, 1, (bf16*)(ws + B_RNN), DRNN, 0, 11, 0};
                pg8::gemm_phase<pg8::EpiGen, pg8::StaticOrder, true, true>(lds, g, S, E);
            }
            if (kind == 0) {
                __syncthreads();
                pg8::Gemm g{(const bf16*)(ws + W_MIX) + (size_t)GH * DM, XN, DM, DM, DM};
                pg8::StaticOrder S; S.init(16, 96, G, bid, DM, DM);
                pg8::EpiGeluStatsT E{(bf16*)(ws + B_VT), MTOK, (pg8::f32x2*)(ws + B_PST)};
                pg8::gemm_phase<pg8::EpiGeluStatsT, pg8::StaticOrder, true, true>(lds, g, S, E);
            }
            SEAMS(1);
        }
        if (INS(2)) {
            if (KIND_ON(0) && kind == 0) {
                const float* Wsp = args.in[I_AWS] + (size_t)jl * NGRP * 128 * 128; const float* bsp = args.in[I_ABS] + (size_t)jl * NGRP * 128;
                for (int u = bid; u < 192 * NGRP; u += G) { const int n = u >> 3, g = u & 7;
                    sgu_unit(n, g, (const bf16*)(ws + B_VT), (const f32x2*)(ws + B_PST), (bf16*)(ws + B_U), Wsp + (size_t)g * 16384, bsp + g * 128,
                             args.in[I_ALNG] + (size_t)jl * GH, args.in[I_ALNB] + (size_t)jl * GH, lds, tid, lane, wave); }
            } else if (KIND_ON(1) && kind == 1) {
                const bf16* QKV = (const bf16*)(ws + B_QKV); bf16* OB = (bf16*)(ws + B_OB);
                LAS float* tab = (LAS float*)(lds + attn::TAB_OFF);
                for (int u = bid; u < NSEQ * 16 * NHEAD; u += G) { const int h = u & 15, qt = (u >> 4) & 15, b = u >> 8;
                    __syncthreads();
                    for (int idx = tid; idx < 768; idx += NTHREADS) { const int rel = idx - 384, n = rel < 0 ? -rel : rel;
                        const int bk = n < 8 ? n : 8 + (n >= 12) + (n >= 16) + (n >= 23) + (n >= 32) + (n >= 46) + (n >= 64) + (n >= 91);
                        tab[idx] = n <= 128 ? args.in[I_REL][((rel > 0 ? 16 : 0) + bk) * NHEAD + h] * (1.0f / attn::SCALE) : -1e30f; }
                    const int klo = qt * 256 - 128 < 0 ? 0 : qt * 256 - 128, khi = qt * 256 + 384 > SEQ ? SEQ : qt * 256 + 384;
                    const size_t row0 = (size_t)b * SEQ + qt * 256, krow0 = (size_t)b * SEQ + klo; const int kv = h >> 2;
                    attn::attn_unit<true, QKVW, QKVW, DM, 1>(QKV + row0 * QKVW + h * 128, QKV + krow0 * QKVW + 2048 + kv * 128, QKV + krow0 * QKVW + 2560 + kv * 128,
                                          OB + row0 * DM + h * 128, (khi - klo) / 64, qt * 256, klo, args.in[I_BSINK][h], (char*)lds_raw);
                }
            } else if (KIND_ON(2)) {
                conv_phase((const bf16*)(ws + B_RNN), args.in[I_CCONVW], args.in[I_CCONVB], (bf16*)(ws + B_XC), gt, NGT);
            }
            SEAMS(2);
        }
        if (kind == 2) {
            if (INS(3)) {
                pg8::Gemm g{(const bf16*)(ws + B_XC), (const bf16*)(ws + W_GATES), 4096, 256, 256};
                pg8::GateOrder S{G, bid};
                pg8::EpiLRU E{(_Float16*)(ws + B_LA), (_Float16*)(ws + B_UU), (const bf16*)(ws + B_XC), args.in[I_CBA], args.in[I_CBX], (const float*)(ws + W_SPL), (unsigned)(MTOK * DRNN)};
                pg8::gemm_phase<pg8::EpiLRU, pg8::GateOrder, true, true>(lds, g, S, E);
                SEAMS(3);
            }
            if (INS(4)) { scan1_phase((_Float16*)(ws + B_LA), (_Float16*)(ws + B_UU), (float*)(ws + B_CAR), (float*)(ws + B_CAR) + (size_t)NSEQ * 2 * 64 * DRNN, gw, NGW, lane); SEAMS(4); }
            if (INS(5)) { scan2_phase((const _Float16*)(ws + B_LA), (const _Float16*)(ws + B_UU), (const float*)(ws + B_CAR), (const float*)(ws + B_CAR) + (size_t)NSEQ * 2 * 64 * DRNN, (bf16*)(ws + B_GATE), gw, NGW, lane); SEAMS(5); }
        }
        if (INS(6)) {
            const bf16* A = kind == 0 ? (const bf16*)(ws + B_U) : (kind == 1 ? (const bf16*)(ws + B_OB) : (const bf16*)(ws + B_GATE));
            const int K = kind == 0 ? GH : (kind == 1 ? DM : DRNN);
            pg8::Gemm g{A, (const bf16*)(ws + W_MIX2), K, K, K};
            pg8::StaticOrder S; S.init(96, 8, G, bid, K, K);
            pg8::EpiGen E{HB, DM, 0, nullptr, 0, 0, 1 << 30, 0};
            pg8::gemm_phase<pg8::EpiGen, pg8::StaticOrder, true, true>(lds, g, S, E);
            SEAMS(6);
        }
        if (INS(7)) {
            norm_pass<1>(nullptr, nullptr, X, HB, gN + 1 * DM, gN + 2 * DM, XN, gw, NGW, lane);
            mem_norm(args.in[I_MP], args.in[I_MS], gN + 4 * DM, XN, gw, NGW, lane);
            SEAMS(7);
        }
        if (INS(8)) {
            pg8::Gemm g{XN, (const bf16*)(ws + W_MQKV), DM, DM, DM};
            pg8::MemProjOrder S{G, bid, (size_t)256 * DM * 2, (size_t)256 * DM * 2};
            pg8::EpiGen E{(bf16*)(ws + B_QM), MEMW, 0, (bf16*)(ws + B_KVM), 2 * MEMW, 0, 2, 96};
            pg8::gemm_phase<pg8::EpiGen, pg8::MemProjOrder, true, true>(lds, g, S, E);
            SEAMS(8);
        }
        if (INS(9)) {
            const bf16* QM = (const bf16*)(ws + B_QM); const bf16* KVM = (const bf16*)(ws + B_KVM); bf16* OM = (bf16*)(ws + B_OM);
            for (int u = bid; u < 96 * 4; u += G) { const int h = u & 3, pm = u >> 2, b = pm >> 4;
                __syncthreads();
                attn::attn_unit<false, MEMW, 2 * MEMW, MEMW, 2>(QM + (size_t)pm * 256 * MEMW + h * 128, KVM + (size_t)b * MEMLEN * 2 * MEMW + h * 128, KVM + (size_t)b * MEMLEN * 2 * MEMW + MEMW + h * 128,
                                       OM + (size_t)pm * 256 * MEMW + h * 128, 4, 0, 0, 0.f, (char*)lds_raw);
            }
            SEAMS(9);
        }
        if (INS(10)) {
            pg8::Gemm g{(const bf16*)(ws + B_OM), (const bf16*)(ws + W_MO), MEMW, MEMW, MEMW};
            pg8::StaticOrder S; S.init(96, 8, G, bid, MEMW, MEMW);
            pg8::EpiGen E{HB, DM, 0, nullptr, 0, 0, 1 << 30, 0};
            pg8::gemm_phase<pg8::EpiGen, pg8::StaticOrder, true, true>(lds, g, S, E);
            SEAMS(10);
        }
        if (INS(11)) { norm_pass<1>(nullptr, nullptr, X, HB, gN + 3 * DM, gN + 5 * DM, XN, gw, NGW, lane); SEAMS(11); }
        if (INS(12)) {
            pg8::Gemm g{XN, (const bf16*)(ws + W_GU), DM, DM, DM};
            pg8::StaticOrder S; S.init(96, 44, G, bid, DM, DM);
            pg8::EpiSwiGLU E{(bf16*)(ws + B_HF), DFF};
            pg8::gemm_phase<pg8::EpiSwiGLU, pg8::StaticOrder, true, true>(lds, g, S, E);
            SEAMS(12);
        }
        if (INS(13)) {
            pg8::Gemm g{(const bf16*)(ws + B_HF), (const bf16*)(ws + W_DN), DFF, DFF, DFF};
            pg8::StaticOrder S; S.init(96, 8, G, bid, DFF, DFF);
            pg8::EpiGen E{HB, DM, 0, nullptr, 0, 0, 1 << 30, 0};
            pg8::gemm_phase<pg8::EpiGen, pg8::StaticOrder, true, true>(lds, g, S, E);
            SEAMS(13);
        }
        if (INS(14)) {
            if (L + 1 < DEPTH) norm_pass<1>(nullptr, nullptr, X, HB, gN + 6 * DM, gN + NNORM * DM, XN, gw, NGW, lane);
            else               norm_pass<2>(nullptr, nullptr, X, HB, gN + 6 * DM, nullptr, nullptr, gw, NGW, lane);
            SEAMS(14);
        }
    }
#undef INS
#undef SEAMS
}

extern "C" void kernel_launch(void* const* d_in, const int* in_sizes, int n_in, void* d_out, int out_size, void* d_ws, size_t ws_size, hipStream_t stream) {
    static int grid = 0;
    if (grid == 0) {
        if (n_in != N_IN || in_sizes[0] != NPROMPT * DM || out_size != MTOK * DM || ws_size < WS_END) {
            fprintf(stderr, "kernel_launch: unexpected shapes: n_in %d in0 %d out %d ws %zu (need %zu); nothing launched\n", n_in, n_in > 0 ? in_sizes[0] : -1, out_size, ws_size, (size_t)WS_END); grid = -1; return; }
        int dev = 0, cus = 0, per_cu = 0;
        if (hipGetDevice(&dev) != hipSuccess || hipDeviceGetAttribute(&cus, hipDeviceAttributeMultiprocessorCount, dev) != hipSuccess) { fprintf(stderr, "kernel_launch: device query failed\n"); grid = -1; return; }
        if (hipFuncSetAttribute((const void*)fwd, hipFuncAttributeMaxDynamicSharedMemorySize, LDS_BYTES) != hipSuccess) { fprintf(stderr, "kernel_launch: hipFuncSetAttribute failed\n"); grid = -1; return; }
        if (hipOccupancyMaxActiveBlocksPerMultiprocessor(&per_cu, (const void*)fwd, NTHREADS, LDS_BYTES) != hipSuccess || per_cu < 1)
            fprintf(stderr, "kernel_launch: note: occupancy query reports %d workgroups per CU\n", per_cu);
        (void)hipGetLastError();
        grid = cus;
    }
    if (grid < 0) return;
    if (hipMemsetAsync((char*)d_ws + WS_CTL, 0, CTL_ZERO_BYTES, stream) != hipSuccess) { fprintf(stderr, "kernel_launch: memset failed\n"); return; }
    Args a{};
    for (int i = 0; i < N_IN; ++i) a.in[i] = (const float*)d_in[i];
    a.out = (float*)d_out; a.ws = (unsigned char*)d_ws;
#if MK_MULTI
    for (int L = 0; L < DEPTH; ++L)
        for (int s = 0; s < 15; ++s) {
            const int kind = L % 3;
            if (!(s <= 2 || (s >= 3 && s <= 5 && kind == 2) || s >= 6)) continue;
            a.ph_lo = L * 16 + s; a.ph_hi = a.ph_lo + 1;
            hipLaunchKernelGGL(fwd, dim3(grid), dim3(NTHREADS), LDS_BYTES, stream, a);
        }
#else
    a.ph_lo = 0; a.ph_hi = DEPTH * 16;
    hipLaunchKernelGGL(fwd, dim3(grid), dim3(NTHREADS), LDS_BYTES, stream, a);
#endif
    const hipError_t le = hipPeekAtLastError();
    if (le != hipSuccess) fprintf(stderr, "kernel_launch: launch failed: %s\n", hipGetErrorName(le));
}
```
